# Optimizing an MI355X kernel written in HIP

```python
import math
import jax, jax.numpy as jnp
from jax import lax
import numpy as np

D_MODEL = 1024
BATCH = 32
SEQ = 2048
DEPTH = 1
DEC_BATCH = 16
DEC_SEQ = 2048
PAST_LEN = 128

GRID_W = 64
Q_BLOCK = 128
EPS = 1e-6
ROPE_THETA = 10000.0
A_HEADS = 8
A_KV_HEADS = 2
A_GROUP = A_HEADS // A_KV_HEADS
A_HEAD_DIM = 64
A_WIDTH = A_HEADS * A_HEAD_DIM
A_KV_WIDTH = A_KV_HEADS * A_HEAD_DIM
B_HEADS = 4
B_HEAD_DIM = 64
B_V_DIM = 2 * B_HEAD_DIM
B_QK_WIDTH = B_HEADS * 2 * B_HEAD_DIM
B_WIDTH = B_HEADS * B_V_DIM
SPLIT_SIZES = (A_WIDTH, A_KV_WIDTH, A_KV_WIDTH, A_WIDTH,
               B_QK_WIDTH, B_QK_WIDTH, B_WIDTH, B_WIDTH,
               D_MODEL, D_MODEL)
D_IN = sum(SPLIT_SIZES)

kernel_name = "hybrid_gqa_diffattn_gated_encoder"


def rmsnorm(x, g):
    xf = x.astype(jnp.float32)
    y = xf * lax.rsqrt(jnp.mean(xf * xf, axis=-1, keepdims=True) + EPS)
    return (y * g.astype(jnp.float32)).astype(x.dtype)


def axial_rope_tables(seq_len):
    rows = seq_len // GRID_W
    row = jnp.repeat(jnp.arange(rows), GRID_W).astype(jnp.float32)
    col = jnp.tile(jnp.arange(GRID_W), rows).astype(jnp.float32)
    axis_dim = A_HEAD_DIM // 2
    inv_freq = ROPE_THETA ** (-jnp.arange(0, axis_dim, 2, dtype=jnp.float32) / axis_dim)
    ang_r = row[:, None, None] * inv_freq
    ang_c = col[:, None, None] * inv_freq
    return jnp.cos(ang_r), jnp.sin(ang_r), jnp.cos(ang_c), jnp.sin(ang_c)


def _rotate_half(x, cos, sin):
    x1, x2 = jnp.split(x, 2, axis=-1)
    return jnp.concatenate([x1 * cos - x2 * sin, x2 * cos + x1 * sin], axis=-1)


def axial_rope(x, tables):
    cos_r, sin_r, cos_c, sin_c = tables
    xr, xc = jnp.split(x.astype(jnp.float32), 2, axis=-1)
    out = jnp.concatenate([_rotate_half(xr, cos_r, sin_r), _rotate_half(xc, cos_c, sin_c)], axis=-1)
    return out.astype(x.dtype)


def gqa_attention(q, k, v):
    bn, s = q.shape[0], q.shape[1]
    nblk = s // Q_BLOCK
    qb = q.reshape(bn, nblk, Q_BLOCK, A_KV_HEADS, A_GROUP, A_HEAD_DIM).transpose(1, 0, 2, 3, 4, 5)
    kf = k.astype(jnp.float32)
    scale = A_HEAD_DIM ** -0.5

    def block(qi):
        sc = jnp.einsum('bqkgd,bskd->bkgqs', qi.astype(jnp.float32), kf) * scale
        p = jax.nn.softmax(sc, axis=-1).astype(v.dtype)
        return jnp.einsum('bkgqs,bskd->bqkgd', p, v)

    o = lax.map(block, qb)
    return o.transpose(1, 0, 2, 3, 4, 5).reshape(bn, s, A_WIDTH)


def alibi_slopes(n_heads):
    h = jnp.arange(1, n_heads + 1, dtype=jnp.float32)
    return 2.0 ** (-8.0 * h / n_heads)


def diff_attention(q1, q2, k1, k2, v, lam):
    bn, s = q1.shape[0], q1.shape[1]
    nblk = s // Q_BLOCK
    def to_blocks(a):
        return a.reshape(bn, nblk, Q_BLOCK, B_HEADS, B_HEAD_DIM).transpose(1, 0, 2, 3, 4)
    starts = jnp.arange(nblk) * Q_BLOCK
    k1f = k1.astype(jnp.float32)
    k2f = k2.astype(jnp.float32)
    slopes = alibi_slopes(B_HEADS)
    kpos = jnp.arange(s)
    scale = B_HEAD_DIM ** -0.5

    def block(args):
        q1i, q2i, start = args
        qpos = start + jnp.arange(Q_BLOCK)
        dist = jnp.abs(qpos[:, None] - kpos[None, :]).astype(jnp.float32)
        bias = -slopes[:, None, None] * dist
        s1 = jnp.einsum('bqhd,bshd->bhqs', q1i.astype(jnp.float32), k1f) * scale + bias
        s2 = jnp.einsum('bqhd,bshd->bhqs', q2i.astype(jnp.float32), k2f) * scale + bias
        p = jax.nn.softmax(s1, axis=-1) - lam * jax.nn.softmax(s2, axis=-1)
        return jnp.einsum('bhqs,bshe->bqhe', p.astype(v.dtype), v)

    o = lax.map(block, (to_blocks(q1), to_blocks(q2), starts))
    return o.transpose(1, 0, 2, 3, 4).reshape(bn, s, B_HEADS, B_V_DIM)


def encoder_trunk(x, c, w_ada, b_ada, norm_g, w_in, a_q_norm, a_k_norm,
                  b_lq1, b_lk1, b_lq2, b_lk2, b_sub_norm, p_a, p_b, w_out, final_g):
    bn, s, _ = x.shape
    rope = axial_rope_tables(s)
    c_act = jax.nn.silu(c)
    split_points = np.cumsum(SPLIT_SIZES)[:-1].tolist()
    for l in range(DEPTH):
        ada = c_act @ w_ada[l] + b_ada[l]
        shift, scl, gate = jnp.split(ada[:, None, :], 3, axis=-1)
        h = rmsnorm(x, norm_g[l]) * (1.0 + scl) + shift
        proj = h @ w_in[l]
        qa, ka, va, ga, qb, kb, vb, gb, ma, mb = jnp.split(proj, split_points, axis=-1)

        qa = axial_rope(rmsnorm(qa.reshape(bn, s, A_HEADS, A_HEAD_DIM), a_q_norm[l]), rope)
        ka = axial_rope(rmsnorm(ka.reshape(bn, s, A_KV_HEADS, A_HEAD_DIM), a_k_norm[l]), rope)
        va = va.reshape(bn, s, A_KV_HEADS, A_HEAD_DIM)
        oa = gqa_attention(qa.reshape(bn, s, A_KV_HEADS, A_GROUP, A_HEAD_DIM), ka, va)
        ya = (oa * jax.nn.silu(ga)) @ p_a[l]

        lam_init = 0.8 - 0.6 * math.exp(-0.3 * l)
        lam = (jnp.exp(jnp.sum(b_lq1[l].astype(jnp.float32) * b_lk1[l].astype(jnp.float32)))
               - jnp.exp(jnp.sum(b_lq2[l].astype(jnp.float32) * b_lk2[l].astype(jnp.float32)))
               + lam_init)
        qb = qb.reshape(bn, s, B_HEADS, 2, B_HEAD_DIM)
        kb = kb.reshape(bn, s, B_HEADS, 2, B_HEAD_DIM)
        vb = vb.reshape(bn, s, B_HEADS, B_V_DIM)
        ob = diff_attention(qb[..., 0, :], qb[..., 1, :], kb[..., 0, :], kb[..., 1, :], vb, lam)
        ob = (rmsnorm(ob, b_sub_norm[l]) * (1.0 - lam_init)).reshape(bn, s, B_WIDTH)
        yb = (ob * jax.nn.silu(gb)) @ p_b[l]

        merged = jax.nn.sigmoid(ma) * ya + jax.nn.sigmoid(mb) * yb
        x = x + gate * (merged @ w_out[l])
    return rmsnorm(x, final_g)


def setup_inputs(seed: int = 0) -> dict:
    key = jax.random.key(seed)
    ks = jax.random.split(key, 24)
    f32 = jnp.float32
    def nrm(k, shape, s):
        return jax.random.normal(k, shape, f32) * s
    def gain(k, shape):
        return 1.0 + 0.01 * jax.random.normal(k, shape, f32)
    return {
        "x_prompt": nrm(ks[0], (BATCH, SEQ, D_MODEL), 1.0),
        "x_sample": nrm(ks[1], (DEC_BATCH, DEC_SEQ, D_MODEL), 1.0),
        "c_prompt": nrm(ks[2], (BATCH, D_MODEL), 1.0),
        "c_sample": nrm(ks[3], (DEC_BATCH, D_MODEL), 1.0),
        "w_ada": nrm(ks[4], (DEPTH, D_MODEL, 3 * D_MODEL), D_MODEL ** -0.5),
        "b_ada": nrm(ks[5], (DEPTH, 3 * D_MODEL), 0.01),
        "norm_g": gain(ks[6], (DEPTH, D_MODEL)),
        "w_in": nrm(ks[7], (DEPTH, D_MODEL, D_IN), D_MODEL ** -0.5),
        "a_q_norm": gain(ks[8], (DEPTH, A_HEAD_DIM)),
        "a_k_norm": gain(ks[9], (DEPTH, A_HEAD_DIM)),
        "b_lq1": nrm(ks[10], (DEPTH, B_HEAD_DIM), 0.1),
        "b_lk1": nrm(ks[11], (DEPTH, B_HEAD_DIM), 0.1),
        "b_lq2": nrm(ks[12], (DEPTH, B_HEAD_DIM), 0.1),
        "b_lk2": nrm(ks[13], (DEPTH, B_HEAD_DIM), 0.1),
        "b_sub_norm": gain(ks[14], (DEPTH, B_V_DIM)),
        "p_a": nrm(ks[15], (DEPTH, A_WIDTH, D_MODEL), A_WIDTH ** -0.5),
        "p_b": nrm(ks[16], (DEPTH, B_WIDTH, D_MODEL), B_WIDTH ** -0.5),
        "w_out": nrm(ks[17], (DEPTH, D_MODEL, D_MODEL), D_MODEL ** -0.5),
        "final_g": gain(ks[18], (D_MODEL,)),
    }


def reference(x_prompt, x_sample, c_prompt, c_sample, w_ada, b_ada, norm_g, w_in,
              a_q_norm, a_k_norm, b_lq1, b_lk1, b_lq2, b_lk2, b_sub_norm,
              p_a, p_b, w_out, final_g):
    y_prompt = encoder_trunk(x_prompt, c_prompt, w_ada, b_ada, norm_g, w_in, a_q_norm, a_k_norm,
                             b_lq1, b_lk1, b_lq2, b_lk2, b_sub_norm, p_a, p_b, w_out, final_g)
    y_sample = encoder_trunk(x_sample, c_sample, w_ada, b_ada, norm_g, w_in, a_q_norm, a_k_norm,
                             b_lq1, b_lk1, b_lq2, b_lk2, b_sub_norm, p_a, p_b, w_out, final_g)
    return (y_prompt, y_sample)
```

```cpp
#include <hip/hip_runtime.h>
#include <hip/hip_cooperative_groups.h>
#include <cstdio>
#include <cstdint>
namespace cg = cooperative_groups;
#ifndef ATT_REPS
#define ATT_REPS 1
#endif
#ifndef P2_REPS
#define P2_REPS 1
#endif

constexpr int D = 1024, SEQ = 2048, NB_P = 32, NB_S = 16, NB = NB_P + NB_S, M = NB * SEQ, MP = NB_P * SEQ, DIN = 5376;
constexpr int C_QA = 0, C_KA = 512, C_VA = 640, C_GA = 768, C_QB = 1280, C_KB = 1792, C_VB = 2304, C_GB = 2816, C_MA = 3328, C_MB = 4352, C_MERGED = 1280;
constexpr float EPS = 1e-6f, LOG2E = 1.4426950408889634f, QSCALE = 0.125f * LOG2E, LAM_INIT = 0.2f;
constexpr size_t MiB = 1u << 20;
constexpr size_t WS_PROJ = 0, WS_WOUT = 1008 * MiB, WS_ADA = 1010 * MiB, WS_RSS = 1011 * MiB, WS_BAR = 1017 * MiB, WS_END = 1018 * MiB;
static_assert((size_t)M * DIN * 2 == 1008 * MiB, "proj size");
constexpr size_t DO_H = 0, DO_WIN = 192 * MiB, DO_PA = 203 * MiB, DO_PB = 204 * MiB;
constexpr int NWAVES = 8, NTHREADS = 512, LDS_BYTES = 147456;

typedef unsigned short bf16_t;
__device__ __forceinline__ float bf_lo(unsigned w) { return __builtin_bit_cast(float, w << 16); }
__device__ __forceinline__ float bf_hi(unsigned w) { return __builtin_bit_cast(float, w & 0xffff0000u); }
__device__ __forceinline__ float sigmoidf_(float v) { return __builtin_amdgcn_rcpf(1.f + __builtin_amdgcn_exp2f(-v * LOG2E)); }

namespace pg8 {
#define PG8_LAS __attribute__((address_space(3)))
typedef short bf16x8 __attribute__((ext_vector_type(8)));
typedef float f32x4 __attribute__((ext_vector_type(4)));
typedef unsigned u32x4 __attribute__((ext_vector_type(4)));
constexpr int BM = 256, BK = 64, HALF = 128, HTB = HALF * BK * 2  , STAGE_BYTES = 8 * HTB, NXCD = 8, WGM = 8;

__host__ __device__ __forceinline__ int lds_byte(int r, int c) { const int st = (r >> 4) * 2 + (c >> 5), rr = r & 15, cc = c & 31, ob = rr * 64 + cc * 2; return st * 1024 + (ob ^ (((ob >> 9) & 1) << 5)); }
__host__ __device__ __forceinline__ void stage_rc(int b, int& R, int& C) { const int st = b / 1024, sb = b % 1024, swz = sb ^ (((sb >> 9) & 1) << 5); R = (st >> 1) * 16 + swz / 64; C = (st & 1) * 32 + (swz % 64) / 2; }
__host__ __device__ __forceinline__ int perm32(int rho) { const int n = rho >> 4, i = rho & 15; return 8 * (i >> 2) + 4 * n + (i & 3); }

struct Unit { int pm, pn; };
struct Gemm { const bf16_t* A; const bf16_t* Bt; int M, N, K, lda; };

struct StaticOrder {
    int nM, nN, nwg, G, c;
    __host__ __device__ void init(int M, int N, int G_, int c_) { nM = M / BM; nN = N / BM; nwg = nM * nN; G = G_; c = c_; }
    __host__ __device__ bool next(int i, Unit& u) const {
        const long L = (long)i * G + c; if (L >= nwg) return false;
        int wgid = (int)L; { const int q = nwg / NXCD, r = nwg % NXCD, xcd = wgid % NXCD, off = wgid / NXCD; wgid = (xcd < r ? xcd * (q + 1) : r * (q + 1) + (xcd - r) * q) + off; }
        const int nig = WGM * nN, gid = wgid / nig, fm = gid * WGM, gsz = (nM - fm) < WGM ? (nM - fm) : WGM;
        u.pm = fm + ((wgid % nig) % gsz); u.pn = (wgid % nig) / gsz; return true;
    }
    __device__ __forceinline__ void a_ready(const Unit&) const {}
    __device__ __forceinline__ void done(const Unit&) const {}
};

__device__ __forceinline__ unsigned cvt_pk_bf16(float lo, float hi) { unsigned r; asm volatile("v_cvt_pk_bf16_f32 %0, %1, %2" : "=v"(r) : "v"(lo), "v"(hi)); return r; }

typedef unsigned u32x2 __attribute__((ext_vector_type(2)));

struct EpiInProj {
    static constexpr bool PERM = true, AFTER_DRAIN = false;
    bf16_t* P; const float* gq; const float* gk;
    __device__ __forceinline__ void operator()(const f32x4 (&acc)[2][2][4][2], const Unit& u, int wr, int wc, int fr_in, int fq_in) const {
        int fr = fr_in, fq = fq_in; asm volatile("" : "+v"(fr), "+v"(fq));
        const int row0 = u.pm * BM + wr * 64 + fr; const int pn = u.pn;
        if (pn < 2 || (pn == 2 && wc < 2)) {
            const bool isq = pn < 2; const float* gs = isq ? gq : gk;
            f32x4 gv[2][2];
#pragma unroll
            for (int bj = 0; bj < 2; ++bj)
#pragma unroll
                for (int n = 0; n < 2; ++n) gv[bj][n] = *(const f32x4*)(gs + 32 * bj + 16 * n + 4 * fq);
            float invf[4];
#pragma unroll
            for (int e = 0; e < 4; ++e) invf[e] = __builtin_amdgcn_exp2f(-(float)(4 * fq + e) * 0.8304820237f) * 0.15915494309f;
            const float qs = isq ? QSCALE : 1.f; const int cbase = (isq ? pn * 256 : C_KA) + 64 * wc;
#pragma unroll
            for (int ai = 0; ai < 2; ++ai)
#pragma unroll
                for (int m = 0; m < 4; ++m) {
                    const int row = row0 + ai * HALF + m * 16; const int t = row & (SEQ - 1);
                    float ss = 0.f;
#pragma unroll
                    for (int bj = 0; bj < 2; ++bj)
#pragma unroll
                        for (int n = 0; n < 2; ++n) { const f32x4 v = acc[ai][bj][m][n]; ss += (v[0] * v[0] + v[1] * v[1]) + (v[2] * v[2] + v[3] * v[3]); }
                    ss += __shfl_xor(ss, 16); ss += __shfl_xor(ss, 32);
                    const float rs = __builtin_amdgcn_rsqf(ss * (1.f / 64.f) + EPS);
                    bf16_t* rowp = P + (size_t)row * DIN + cbase + 4 * fq;
#pragma unroll
                    for (int bj = 0; bj < 2; ++bj) {
                        const float pos = (float)(bj == 0 ? (t >> 6) : (t & 63));
                        const f32x4 x1 = acc[ai][bj][m][0] * rs * gv[bj][0], x2 = acc[ai][bj][m][1] * rs * gv[bj][1];
                        f32x4 o1, o2;
#pragma unroll
                        for (int e = 0; e < 4; ++e) { const float a = pos * invf[e]; const float c = __builtin_amdgcn_cosf(a), s = __builtin_amdgcn_sinf(a);
                            o1[e] = (x1[e] * c - x2[e] * s) * qs; o2[e] = (x2[e] * c + x1[e] * s) * qs; }
                        u32x2 w1, w2; w1.x = cvt_pk_bf16(o1[0], o1[1]); w1.y = cvt_pk_bf16(o1[2], o1[3]); w2.x = cvt_pk_bf16(o2[0], o2[1]); w2.y = cvt_pk_bf16(o2[2], o2[3]);
                        *(u32x2*)(rowp + 32 * bj) = w1; *(u32x2*)(rowp + 32 * bj + 16) = w2;
                    }
                }
        } else {
            int cb; int act;
            if (pn == 2) { cb = C_VA + (wc - 2) * 64 + 8 * fq; act = 0; }
            else { cb = pn * 256 + wc * 32 + 8 * fq; act = (pn <= 4 || pn == 11 || pn == 12) ? 1 : (pn >= 13 ? 2 : (pn <= 6 ? 3 : 0)); }
            const int bjs = (pn == 2) ? 32 : HALF;
#pragma unroll
            for (int ai = 0; ai < 2; ++ai)
#pragma unroll
                for (int m = 0; m < 4; ++m) { bf16_t* rowp = P + (size_t)(row0 + ai * HALF + m * 16) * DIN + cb;
#pragma unroll
                    for (int bj = 0; bj < 2; ++bj) { f32x4 v0 = acc[ai][bj][m][0], v1 = acc[ai][bj][m][1];
                        if (act == 1) {
#pragma unroll
                            for (int e = 0; e < 4; ++e) { v0[e] = v0[e] * sigmoidf_(v0[e]); v1[e] = v1[e] * sigmoidf_(v1[e]); }
                        } else if (act == 2) {
#pragma unroll
                            for (int e = 0; e < 4; ++e) { v0[e] = sigmoidf_(v0[e]); v1[e] = sigmoidf_(v1[e]); }
                        } else if (act == 3) { v0 = v0 * QSCALE; v1 = v1 * QSCALE; }
                        u32x4 w; w.x = cvt_pk_bf16(v0[0], v0[1]); w.y = cvt_pk_bf16(v0[2], v0[3]); w.z = cvt_pk_bf16(v1[0], v1[1]); w.w = cvt_pk_bf16(v1[2], v1[3]);
                        *(u32x4*)(rowp + bj * bjs) = w; } }
        }
    }
};
template <int MODE> struct EpiMerge {
    static constexpr bool PERM = true, AFTER_DRAIN = false;
    bf16_t* P;
    __device__ __forceinline__ void operator()(const f32x4 (&acc)[2][2][4][2], const Unit& u, int wr, int wc, int fr_in, int fq_in) const {
        int fr = fr_in, fq = fq_in; asm volatile("" : "+v"(fr), "+v"(fq));
        const int row0 = u.pm * BM + wr * 64 + fr; const int col0 = u.pn * BM + wc * 32 + 8 * fq;
#pragma unroll
        for (int ai = 0; ai < 2; ++ai)
#pragma unroll
            for (int m = 0; m < 4; ++m) { bf16_t* rowp = P + (size_t)(row0 + ai * HALF + m * 16) * DIN + col0;
#pragma unroll
                for (int bj = 0; bj < 2; ++bj) { const f32x4 v0 = acc[ai][bj][m][0], v1 = acc[ai][bj][m][1];
                    const u32x4 s = *(const u32x4*)(rowp + C_MA + bj * HALF);
                    float o[8];
                    if (MODE == 0) {
                        o[0] = bf_lo(s.x) * v0[0]; o[1] = bf_hi(s.x) * v0[1]; o[2] = bf_lo(s.y) * v0[2]; o[3] = bf_hi(s.y) * v0[3];
                        o[4] = bf_lo(s.z) * v1[0]; o[5] = bf_hi(s.z) * v1[1]; o[6] = bf_lo(s.w) * v1[2]; o[7] = bf_hi(s.w) * v1[3];
                    } else {
                        const u32x4 g = *(const u32x4*)(rowp + C_MB + bj * HALF);
                        o[0] = bf_lo(s.x) + bf_lo(g.x) * v0[0]; o[1] = bf_hi(s.x) + bf_hi(g.x) * v0[1]; o[2] = bf_lo(s.y) + bf_lo(g.y) * v0[2]; o[3] = bf_hi(s.y) + bf_hi(g.y) * v0[3];
                        o[4] = bf_lo(s.z) + bf_lo(g.z) * v1[0]; o[5] = bf_hi(s.z) + bf_hi(g.z) * v1[1]; o[6] = bf_lo(s.w) + bf_lo(g.w) * v1[2]; o[7] = bf_hi(s.w) + bf_hi(g.w) * v1[3];
                    }
                    u32x4 w; w.x = cvt_pk_bf16(o[0], o[1]); w.y = cvt_pk_bf16(o[2], o[3]); w.z = cvt_pk_bf16(o[4], o[5]); w.w = cvt_pk_bf16(o[6], o[7]);
                    *(u32x4*)(rowp + (MODE == 0 ? C_MA : C_MERGED) + bj * HALF) = w; } }
    }
};
struct EpiOut {
    static constexpr bool PERM = true, AFTER_DRAIN = false;
    const float* xp; const float* xs; const float* ada; bf16_t* yb; float* rss;
    __device__ __forceinline__ void operator()(const f32x4 (&acc)[2][2][4][2], const Unit& u, int wr, int wc, int fr_in, int fq_in) const {
        int fr = fr_in, fq = fq_in; asm volatile("" : "+v"(fr), "+v"(fq));
        const int row0 = u.pm * BM + wr * 64 + fr; const int col0 = u.pn * BM + wc * 32 + 8 * fq;
        const int tile_row = u.pm * BM; const float* xb = tile_row < MP ? xp + (size_t)tile_row * D : xs + (size_t)(tile_row - MP) * D;
        const float* gp = ada + (size_t)(tile_row / SEQ) * (3 * D) + 2 * D + col0;
        f32x4 gv[2][2];
#pragma unroll
        for (int bj = 0; bj < 2; ++bj)
#pragma unroll
            for (int n = 0; n < 2; ++n) gv[bj][n] = *(const f32x4*)(gp + bj * HALF + 4 * n);
#pragma unroll
        for (int ai = 0; ai < 2; ++ai)
#pragma unroll
            for (int m = 0; m < 4; ++m) { const int rl = wr * 64 + fr + ai * HALF + m * 16; const size_t off = (size_t)rl * D + col0; float ss = 0.f;
#pragma unroll
                for (int bj = 0; bj < 2; ++bj) { f32x4 y[2];
#pragma unroll
                    for (int n = 0; n < 2; ++n) { const f32x4 xv = *(const f32x4*)(xb + off + bj * HALF + 4 * n); y[n] = xv + gv[bj][n] * acc[ai][bj][m][n];
                        ss += (y[n][0] * y[n][0] + y[n][1] * y[n][1]) + (y[n][2] * y[n][2] + y[n][3] * y[n][3]); }
                    u32x4 w; w.x = cvt_pk_bf16(y[0][0], y[0][1]); w.y = cvt_pk_bf16(y[0][2], y[0][3]); w.z = cvt_pk_bf16(y[1][0], y[1][1]); w.w = cvt_pk_bf16(y[1][2], y[1][3]);
                    *(u32x4*)(yb + (size_t)(tile_row + rl) * DIN + col0 + bj * HALF) = w; }
                ss += __shfl_xor(ss, 16); ss += __shfl_xor(ss, 32);
                if (fq == 0) rss[(size_t)(tile_row + rl) * 16 + u.pn * 4 + wc] = ss; }
    }
};

template <class Epi, class Sched, bool ALIGN_EPI = false, bool SP2 = false>
__device__ __forceinline__ void gemm_phase(PG8_LAS unsigned char* lds, const Gemm g, const Sched& S, const Epi& E) {
    const int tid = threadIdx.x, wid = __builtin_amdgcn_readfirstlane(tid >> 6), lane = tid & 63, wr = wid >> 2, wc = wid & 3, fr = lane & 15, fq = lane >> 4;
    const int K = g.K, nt = K / BK;
    unsigned voffA[2], voffB[2];
#pragma unroll
    for (int i = 0; i < 2; ++i) { int R, C; stage_rc(tid * 16 + i * 8192, R, C); const int Rb = Epi::PERM ? ((R & ~31) + perm32(R & 31)) : R;
        voffA[i] = (unsigned)(R * g.lda + C) * 2u; voffB[i] = (unsigned)(Rb * K + C) * 2u; }
    const size_t kstep = (size_t)(BK * 2);
    const size_t hstep = (size_t)HALF * K * 2;
    const size_t tstep = 2 * hstep; const size_t hstepA = (size_t)HALF * g.lda * 2, tstepA = 2 * hstepA;
    const unsigned ldsw = (unsigned)wid * 1024u;
    const int aoff = lds_byte(wr * 64 + fr, fq * 8), boff = lds_byte(wc * 32 + fr, fq * 8);
#define PG8_SA(b, h) (((b) * 2 + (h)) * HTB)
#define PG8_SB(b, h) ((4 + (b) * 2 + (h)) * HTB)
#define PG8_STAGE(bufoff, gbase, voff) do { _Pragma("unroll") for (int _i = 0; _i < 2; ++_i) \
        __builtin_amdgcn_global_load_lds((const unsigned*)((const char*)(gbase) + (voff)[_i]), (PG8_LAS unsigned*)(lds + (bufoff) + ldsw + _i * 8192), 16, 0, 0); } while (0)
#define PG8_LDA(dst, b, h) do { _Pragma("unroll") for (int m = 0; m < 4; ++m) _Pragma("unroll") for (int k = 0; k < 2; ++k) dst[m][k] = *(const PG8_LAS bf16x8*)(lds + PG8_SA(b, h) + aoff + m * 2048 + k * 1024); } while (0)
#define PG8_LDB(dst, b, h) do { _Pragma("unroll") for (int n = 0; n < 2; ++n) _Pragma("unroll") for (int k = 0; k < 2; ++k) dst[n][k] = *(const PG8_LAS bf16x8*)(lds + PG8_SB(b, h) + boff + n * 2048 + k * 1024); } while (0)
#define PG8_MMA(ai, bj, At, Bt) do { __builtin_amdgcn_s_setprio(1); _Pragma("unroll") for (int m = 0; m < 4; ++m) _Pragma("unroll") for (int n = 0; n < 2; ++n) _Pragma("unroll") for (int k = 0; k < 2; ++k) \
        acc[ai][bj][m][n] = __builtin_amdgcn_mfma_f32_16x16x32_bf16(Bt[n][k], At[m][k], acc[ai][bj][m][n], 0, 0, 0); __builtin_amdgcn_s_setprio(0); } while (0)
#define PG8_WAIT_V(n) asm volatile("s_waitcnt vmcnt(" #n ")" ::: "memory")
#define PG8_WAIT_L(n) asm volatile("s_waitcnt lgkmcnt(" #n ")" ::: "memory")
#define PG8_BAR __builtin_amdgcn_s_barrier()
#define PG8_SCHED __builtin_amdgcn_sched_barrier(0)
    Unit cur, nxt; int ui = 0;
    if (!S.next(0, cur)) return;
    f32x4 acc[2][2][4][2];
#pragma unroll
    for (int a = 0; a < 2; ++a)
#pragma unroll
        for (int b = 0; b < 2; ++b)
#pragma unroll
            for (int m = 0; m < 4; ++m)
#pragma unroll
                for (int n = 0; n < 2; ++n) acc[a][b][m][n] = (f32x4){0.f, 0.f, 0.f, 0.f};
    bf16x8 At[4][2], B0[2][2], B1[2][2];
    const char* cA = (const char*)g.A + (size_t)cur.pm * tstepA; const char* cB = (const char*)g.Bt + (size_t)cur.pn * tstep;
    S.a_ready(cur);
    if constexpr (SP2) {
        PG8_STAGE(PG8_SB(0, 0), cB, voffB); PG8_STAGE(PG8_SB(0, 1), cB + hstep, voffB); PG8_STAGE(PG8_SA(0, 0), cA, voffA); PG8_STAGE(PG8_SA(0, 1), cA + hstepA, voffA);
        if (wr == 1) PG8_BAR;
        PG8_WAIT_V(2); PG8_BAR;
        PG8_STAGE(PG8_SB(1, 0), cB + kstep, voffB); PG8_STAGE(PG8_SA(1, 0), cA + kstep, voffA); PG8_STAGE(PG8_SB(1, 1), cB + hstep + kstep, voffB);
        PG8_WAIT_V(6); PG8_BAR;
    } else {
        PG8_STAGE(PG8_SB(0, 0), cB, voffB); PG8_STAGE(PG8_SA(0, 0), cA, voffA); PG8_STAGE(PG8_SB(0, 1), cB + hstep, voffB); PG8_STAGE(PG8_SA(0, 1), cA + hstepA, voffA);
        if (wr == 1) PG8_BAR;
        PG8_WAIT_V(4); PG8_BAR;
        PG8_STAGE(PG8_SB(1, 0), cB + kstep, voffB); PG8_STAGE(PG8_SA(1, 0), cA + kstep, voffA); PG8_STAGE(PG8_SB(1, 1), cB + hstep + kstep, voffB);
        PG8_WAIT_V(6); PG8_BAR;
    }
    for (;;) {
        const bool has_next = S.next(ui + 1, nxt);
        const char* nA = has_next ? (const char*)g.A + (size_t)nxt.pm * tstepA : cA; const char* nB = has_next ? (const char*)g.Bt + (size_t)nxt.pn * tstep : cB;
        for (int t = 0; t < nt; t += 2) {
            const bool last = (t == nt - 2);
            const char* a1 = cA + (size_t)(t + 1) * kstep;
            const char* a2 = last ? nA : cA + (size_t)(t + 2) * kstep; const char* b2 = last ? nB : cB + (size_t)(t + 2) * kstep;
            const char* a3 = a2 + kstep; const char* b3 = b2 + kstep;
            if (last && has_next) S.a_ready(nxt);
            if constexpr (SP2) {
            PG8_LDB(B0, 0, 0); PG8_LDB(B1, 0, 1); PG8_SCHED; PG8_LDA(At, 0, 0); PG8_STAGE(PG8_SA(1, 1), a1 + hstepA, voffA);
            PG8_WAIT_V(8); PG8_WAIT_L(0); PG8_BAR; PG8_MMA(0, 0, At, B0); PG8_MMA(0, 1, At, B1); PG8_BAR; PG8_SCHED;
            PG8_LDA(At, 0, 1); PG8_STAGE(PG8_SB(0, 0), b2, voffB); PG8_STAGE(PG8_SB(0, 1), b2 + hstep, voffB); PG8_STAGE(PG8_SA(0, 0), a2, voffA);
            PG8_WAIT_V(8); PG8_WAIT_L(0); PG8_BAR; PG8_MMA(1, 0, At, B0); PG8_MMA(1, 1, At, B1); PG8_BAR; PG8_SCHED;
            PG8_LDB(B0, 1, 0); PG8_LDB(B1, 1, 1); PG8_SCHED; PG8_LDA(At, 1, 0); PG8_STAGE(PG8_SA(0, 1), a2 + hstepA, voffA);
            PG8_WAIT_V(8); PG8_WAIT_L(0); PG8_BAR; PG8_MMA(0, 0, At, B0); PG8_MMA(0, 1, At, B1); PG8_BAR; PG8_SCHED;
            PG8_LDA(At, 1, 1); PG8_STAGE(PG8_SB(1, 0), b3, voffB); PG8_STAGE(PG8_SB(1, 1), b3 + hstep, voffB); PG8_STAGE(PG8_SA(1, 0), a3, voffA);
            PG8_WAIT_V(8); PG8_WAIT_L(0); PG8_BAR; PG8_MMA(1, 0, At, B0); PG8_MMA(1, 1, At, B1); PG8_BAR; PG8_SCHED;
            } else {
            PG8_LDB(B0, 0, 0); PG8_SCHED; PG8_LDA(At, 0, 0); PG8_STAGE(PG8_SA(1, 1), a1 + hstepA, voffA);
            PG8_WAIT_L(8); PG8_BAR; PG8_WAIT_L(0); PG8_MMA(0, 0, At, B0); PG8_BAR; PG8_SCHED;
            PG8_LDB(B1, 0, 1); PG8_STAGE(PG8_SB(0, 0), b2, voffB);
            PG8_BAR; PG8_WAIT_L(0); PG8_MMA(0, 1, At, B1); PG8_BAR;
            PG8_LDA(At, 0, 1); PG8_STAGE(PG8_SA(0, 0), a2, voffA);
            PG8_BAR; PG8_WAIT_L(0); PG8_MMA(1, 0, At, B0); PG8_BAR; PG8_SCHED;
            PG8_STAGE(PG8_SB(0, 1), b2 + hstep, voffB);
            PG8_WAIT_V(6); PG8_BAR; PG8_MMA(1, 1, At, B1); PG8_BAR;
            PG8_LDB(B0, 1, 0); PG8_SCHED; PG8_LDA(At, 1, 0); PG8_STAGE(PG8_SA(0, 1), a2 + hstepA, voffA);
            PG8_WAIT_L(8); PG8_BAR; PG8_WAIT_L(0); PG8_MMA(0, 0, At, B0); PG8_BAR; PG8_SCHED;
            PG8_LDB(B1, 1, 1); PG8_STAGE(PG8_SB(1, 0), b3, voffB);
            PG8_BAR; PG8_WAIT_L(0); PG8_MMA(0, 1, At, B1); PG8_BAR;
            PG8_LDA(At, 1, 1); PG8_STAGE(PG8_SA(1, 0), a3, voffA);
            PG8_BAR; PG8_WAIT_L(0); PG8_MMA(1, 0, At, B0); PG8_BAR; PG8_SCHED;
            PG8_STAGE(PG8_SB(1, 1), b3 + hstep, voffB);
            PG8_WAIT_V(6); PG8_BAR; PG8_MMA(1, 1, At, B1); PG8_BAR;
            }
        }
        if constexpr (ALIGN_EPI) { if (wr == 0) PG8_BAR; }
        if constexpr (!Epi::AFTER_DRAIN) { E(acc, cur, wr, wc, fr, fq); S.done(cur); }
        if (!has_next) break;
#pragma unroll
        for (int a = 0; a < 2; ++a)
#pragma unroll
            for (int b = 0; b < 2; ++b)
#pragma unroll
                for (int m = 0; m < 4; ++m)
#pragma unroll
                    for (int n = 0; n < 2; ++n) acc[a][b][m][n] = (f32x4){0.f, 0.f, 0.f, 0.f};
        cur = nxt; cA = nA; cB = nB; ++ui;
        if constexpr (ALIGN_EPI) { if (wr == 1) PG8_BAR; }
    }
    PG8_WAIT_V(0);
    if constexpr (!ALIGN_EPI) { if (wr == 0) PG8_BAR; }
    PG8_BAR;
    if constexpr (Epi::AFTER_DRAIN) { E.fused(acc, cur, wr, wc, fr, fq, lds, wid, lane); S.done(cur); }
#undef PG8_SA
#undef PG8_SB
#undef PG8_STAGE
#undef PG8_LDA
#undef PG8_LDB
#undef PG8_MMA
#undef PG8_WAIT_V
#undef PG8_WAIT_L
#undef PG8_BAR
#undef PG8_SCHED
}
}

namespace att {
#define ALAS __attribute__((address_space(3)))
typedef unsigned short bf16_t;
typedef short bf16x8 __attribute__((ext_vector_type(8)));
typedef short s16x4 __attribute__((ext_vector_type(4)));
typedef float f32x16 __attribute__((ext_vector_type(16)));
typedef float f32x4 __attribute__((ext_vector_type(4)));
typedef unsigned u32x4 __attribute__((ext_vector_type(4)));
typedef unsigned u32x2 __attribute__((ext_vector_type(2)));
typedef float f32x2_t __attribute__((ext_vector_type(2))); typedef __bf16 bf16x2_t __attribute__((ext_vector_type(2)));
typedef short v4i16_t __attribute__((ext_vector_type(4)));
__device__ __forceinline__ unsigned cvtpk(float lo, float hi) { f32x2_t v = {lo, hi}; bf16x2_t b = __builtin_convertvector(v, bf16x2_t); return __builtin_bit_cast(unsigned, b); }
__device__ __forceinline__ float swap_max(float m) { auto rr = __builtin_amdgcn_permlane32_swap(__float_as_uint(m), __float_as_uint(m), false, false); return fmaxf(__uint_as_float(rr[0]), __uint_as_float(rr[1])); }
__device__ __forceinline__ float swap_add(float m) { auto rr = __builtin_amdgcn_permlane32_swap(__float_as_uint(m), __float_as_uint(m), false, false); return __uint_as_float(rr[0]) + __uint_as_float(rr[1]); }
__device__ __forceinline__ float max3f(float a, float b, float c) { float r; asm("v_max3_f32 %0, %1, %2, %3" : "=v"(r) : "v"(a), "v"(b), "v"(c)); return r; }
__device__ __forceinline__ float max2f(float a, float b) { float r; asm("v_max_f32_e32 %0, %1, %2" : "=v"(r) : "v"(a), "v"(b)); return r; }
__device__ __forceinline__ float rowmax(const f32x16& p0, const f32x16& p1) {
    float a = max3f(p0[0], p0[1], p1[0]), b = max3f(p0[2], p0[3], p1[1]); a = max3f(a, p1[2], p1[3]);
#pragma unroll
    for (int r = 4; r < 16; r += 4) { a = max3f(a, p0[r], p0[r + 1]); b = max3f(b, p0[r + 2], p0[r + 3]); a = max3f(a, p1[r], p1[r + 1]); b = max3f(b, p1[r + 2], p1[r + 3]); }
    const float m = max2f(a, b);
    auto rr = __builtin_amdgcn_permlane32_swap(__float_as_uint(m), __float_as_uint(m), false, false);
    return max2f(__uint_as_float(rr[0]), __uint_as_float(rr[1]));
}
__device__ __forceinline__ void glds16(const void* gsrc, unsigned lds_dst) { unsigned keep;
    asm volatile("s_mov_b32 %0, m0\n\ts_mov_b32 m0, %2\n\ts_nop 0\n\tglobal_load_lds_dwordx4 %1, off\n\ts_mov_b32 m0, %0" : "=&s"(keep) : "v"(gsrc), "s"(lds_dst) : "memory"); }
__device__ __forceinline__ s16x4 vtr(const ALAS unsigned char* p) { return __builtin_bit_cast(s16x4, __builtin_amdgcn_ds_read_tr16_b64_v4i16((ALAS v4i16_t*)p)); }

template <bool BR_B>
__device__ __forceinline__ void attn_unit(ALAS unsigned char* lds, bf16_t* P, int b, int head, int qb, float lam, const float* subg, bf16_t* OUTP, int opitch, int ocol_base,
                                          bf16x8 (&qf)[4], bool first, bool has_next, int nb, int nhead, int nqb) {
    constexpr int DV = BR_B ? 128 : 64, NDB = DV / 32, KBYTES = 8192, NK = BR_B ? 2 : 1, VBYTES = DV * 64 * 2, BUF = NK * KBYTES + VBYTES, NT = SEQ / 64;
    int tid = threadIdx.x; asm volatile("" : "+v"(tid));
    const int lane = tid & 63, r = lane & 31, h = lane >> 5; const int wave = __builtin_amdgcn_readfirstlane(tid >> 6);
    const int grp = BR_B ? (wave >> 2) : 0, wq = BR_B ? (wave & 3) : wave;
    const size_t seqrow0 = (size_t)b * SEQ;
    const int q0 = BR_B ? qb * 128 : qb * 256;
    const int qcol = BR_B ? (C_QB + head * 128 + grp * 64) : (C_QA + head * 64);
    const int kcol = BR_B ? (C_KB + head * 128) : (C_KA + (head >> 2) * 64);
    const int vcol = BR_B ? (C_VB + head * 128) : (C_VA + (head >> 2) * 64);
    const int ocol = BR_B ? (C_GB + head * 128) : (C_GA + head * 64);
    const unsigned char* gbase = (const unsigned char*)(P + seqrow0 * DIN);
    unsigned gko, gvo;
    { const int row = 8 * wave + (lane >> 3), c = (lane & 7) ^ ((row >> 1) & 7); gko = (unsigned)(row * DIN + kcol + 8 * c) * 2u;
      const int dh = wave >> 2, rg = wave & 3; gvo = (unsigned)((rg * 16 + (lane >> 2)) * DIN + vcol + dh * 32 + (lane & 3) * 8) * 2u; }
    const unsigned lds0 = (unsigned)(uintptr_t)lds + (unsigned)wave * 1024u;
    const int t0 = BR_B ? (q0 >> 6) : 0;
#define ATT_DMA_KX(t, GB, GKO, T0) do { const unsigned char* gb_ = (GB) + (size_t)(((t) + (T0)) & (NT - 1)) * (64 * DIN * 2); const unsigned lb_ = (unsigned)__builtin_amdgcn_readfirstlane(lds0 + (unsigned)(((t) & 1) * NK * KBYTES)); \
        glds16(gb_ + (GKO), lb_); if (BR_B) glds16(gb_ + (GKO) + 128, lb_ + KBYTES); } while (0)
#define ATT_DMA_VX(t, GB, GVO, T0) do { const unsigned char* gb_ = (GB) + (size_t)(((t) + (T0)) & (NT - 1)) * (64 * DIN * 2); const unsigned lb_ = (unsigned)__builtin_amdgcn_readfirstlane(lds0 + (unsigned)(2 * NK * KBYTES + ((t) & 1) * VBYTES)); \
        glds16(gb_ + (GVO), lb_); if (BR_B) glds16(gb_ + (GVO) + 128, lb_ + 8192); } while (0)
#define ATT_DMA_K(t) ATT_DMA_KX(t, gbase, gko, t0)
#define ATT_DMA_V(t) ATT_DMA_VX(t, gbase, gvo, t0)
    if (first) { ATT_DMA_K(0); ATT_DMA_V(0); ATT_DMA_K(1); }
    if (first) { const bf16_t* qp = P + (seqrow0 + q0 + wq * 32 + r) * DIN + qcol + 8 * h;
#pragma unroll
      for (int d0 = 0; d0 < 4; ++d0) qf[d0] = *(const bf16x8*)(qp + 16 * d0); }
    f32x16 o[NDB];
#pragma unroll
    for (int i = 0; i < NDB; ++i)
#pragma unroll
        for (int j = 0; j < 16; ++j) o[i][j] = 0.f;
    float mref = 0.f, lrun = 0.f;
    const int swz = (r >> 1) & 7;
    int koffs[4];
#pragma unroll
    for (int d0 = 0; d0 < 4; ++d0) koffs[d0] = grp * KBYTES + r * 128 + (((2 * d0 + h) ^ swz) << 4);
    const int voff = 2 * NK * KBYTES + ((lane >> 4) & 1) * 32 + (lane & 3) * 8 + (4 * h + ((lane & 15) >> 2)) * 64;
    const float slope2 = BR_B ? __builtin_amdgcn_exp2f(-2.f * (float)(head + 1)) * LOG2E : 0.f;
    float dq = (float)(4 * h - (q0 + wq * 32 + r)); asm volatile("" : "+v"(dq));
    f32x16 cinit;
#pragma unroll
    for (int j = 0; j < 16; ++j) cinit[j] = 0.f;
#define ATT_BAR() asm volatile("s_waitcnt lgkmcnt(0)\n\ts_barrier" ::: "memory")
#define ATT_QK(S, tt) do { const ALAS unsigned char* kb_ = lds + ((tt) & 1) * (NK * KBYTES); \
        _Pragma("unroll") for (int kvb = 0; kvb < 2; ++kvb) { bf16x8 kf[4]; \
            _Pragma("unroll") for (int d0 = 0; d0 < 4; ++d0) kf[d0] = *(const ALAS bf16x8*)(kb_ + kvb * 4096 + koffs[d0]); \
            _Pragma("unroll") for (int d0 = 0; d0 < 4; ++d0) S[kvb] = __builtin_amdgcn_mfma_f32_32x32x16_bf16(kf[d0], qf[d0], d0 == 0 ? cinit : S[kvb], 0, 0, 0); } } while (0)
#define ATT_BIAS(S, tt) do { if (BR_B) { const float dqt = dq + (float)(64 * (((tt) + t0) & (NT - 1))); \
            _Pragma("unroll") for (int kvb = 0; kvb < 2; ++kvb) _Pragma("unroll") for (int j = 0; j < 16; ++j) { const float dd = dqt + (float)(32 * kvb + (j & 3) + 8 * (j >> 2)); S[kvb][j] = __builtin_fmaf(-slope2, __builtin_fabsf(dd), S[kvb][j]); } } \
        else { asm volatile("s_nop 11" : "+v"(S[0]), "+v"(S[1])); } } while (0)
#define ATT_SUMPACK() do { float ls = 0.f; \
        _Pragma("unroll") for (int kvb = 0; kvb < 2; ++kvb) _Pragma("unroll") for (int j = 0; j < 16; ++j) ls += E[kvb][j]; \
        lrun += ls; \
        _Pragma("unroll") for (int kvb = 0; kvb < 2; ++kvb) _Pragma("unroll") for (int s = 0; s < 2; ++s) { u32x4 w; w.x = cvtpk(E[kvb][8 * s], E[kvb][8 * s + 1]); w.y = cvtpk(E[kvb][8 * s + 2], E[kvb][8 * s + 3]); \
                w.z = cvtpk(E[kvb][8 * s + 4], E[kvb][8 * s + 5]); w.w = cvtpk(E[kvb][8 * s + 6], E[kvb][8 * s + 7]); pa[kvb][s] = __builtin_bit_cast(bf16x8, w); } } while (0)
#define ATT_VRD(db, vb_) do { _Pragma("unroll") for (int ks = 0; ks < 4; ++ks) { const ALAS unsigned char* vp = (vb_) + ((db) * 4 + ks) * 1024; vlo[(db) & 1][ks] = vtr(vp); vhi[(db) & 1][ks] = vtr(vp + 512); } } while (0)
#define ATT_PV(vb_) do { _Pragma("unroll") for (int db = 0; db < NDB; ++db) { if (db + 1 < NDB) ATT_VRD(db + 1, vb_); \
            _Pragma("unroll") for (int ks = 0; ks < 4; ++ks) { const bf16x8 vf = __builtin_shufflevector(vlo[db & 1][ks], vhi[db & 1][ks], 0, 1, 2, 3, 4, 5, 6, 7); \
                o[db] = __builtin_amdgcn_mfma_f32_32x32x16_bf16(vf, pa[ks >> 1][ks & 1], o[db], 0, 0, 0); } } } while (0)
    const int nq0 = BR_B ? nqb * 128 : nqb * 256;
    const int nkcol = BR_B ? (C_KB + nhead * 128) : (C_KA + (nhead >> 2) * 64), nvcol = BR_B ? (C_VB + nhead * 128) : (C_VA + (nhead >> 2) * 64);
    const unsigned char* ngbase = (const unsigned char*)(P + (size_t)nb * SEQ * DIN);
    const unsigned ngko = gko + (unsigned)(nkcol - kcol) * 2u, ngvo = gvo + (unsigned)(nvcol - vcol) * 2u; const int nt0 = BR_B ? (nq0 >> 6) : 0;
    asm volatile("s_waitcnt vmcnt(0)" ::: "memory"); ATT_BAR();
    f32x16 E[2], S[2]; bf16x8 pa[2][2]; s16x4 vlo[2][4], vhi[2][4];
    {
        ATT_QK(E, 0); ATT_BIAS(E, 0);
        const float mx = rowmax(E[0], E[1]);
        mref = mx;
#pragma unroll
        for (int j = 0; j < 16; ++j) cinit[j] = -mref;
#pragma unroll
        for (int kvb = 0; kvb < 2; ++kvb)
#pragma unroll
            for (int j = 0; j < 16; ++j) E[kvb][j] = __builtin_amdgcn_exp2f(E[kvb][j] - mx);
    }
    ATT_BAR();
    bool zE = false; int t = 0;
    while (t < NT - 1) {
    for (; t < NT - 1; ++t) {
        if (t + 2 < NT) ATT_DMA_K(t + 2);
        else if (has_next) ATT_DMA_KX(0, ngbase, ngko, nt0);
        ATT_DMA_V(t + 1);
        const ALAS unsigned char* vb = lds + (t & 1) * VBYTES + voff;
        ATT_QK(S, t + 1);
        ATT_SUMPACK();
#pragma unroll
        for (int i_ = 0; i_ < 8; ++i_) { __builtin_amdgcn_sched_group_barrier(0x008, 1, 0); __builtin_amdgcn_sched_group_barrier(0x002, 6, 0); }
        asm volatile("" : "+v"(pa[0][0]), "+v"(pa[0][1]), "+v"(pa[1][0]), "+v"(pa[1][1]), "+v"(lrun));
        ATT_VRD(0, vb);
        ATT_BIAS(S, t + 1);
        const float mx = rowmax(S[0], S[1]);
        float alpha = 1.f; const bool resc = __any(mx > 8.f);
        if (BR_B) zE = !resc && __all(mx < -136.f);
        if (resc) {
            const float dl = fmaxf(mx, 0.f); mref += dl; alpha = __builtin_amdgcn_exp2f(-dl); lrun *= alpha;
#pragma unroll
            for (int kvb = 0; kvb < 2; ++kvb)
#pragma unroll
                for (int j = 0; j < 16; ++j) S[kvb][j] -= dl;
#pragma unroll
            for (int j = 0; j < 16; ++j) cinit[j] = -mref;
        }
        ATT_PV(vb);
#pragma unroll
        for (int kvb = 0; kvb < 2; ++kvb)
#pragma unroll
            for (int j = 0; j < 16; ++j) E[kvb][j] = __builtin_amdgcn_exp2f(S[kvb][j]);
#pragma unroll
        for (int i_ = 0; i_ < NDB * 4; ++i_) { __builtin_amdgcn_sched_group_barrier(0x008, 1, 1); __builtin_amdgcn_sched_group_barrier(0x402, 32 / (NDB * 4), 1); }
        asm volatile("" : "+v"(E[0]), "+v"(E[1]));
        if (resc) {
#pragma unroll
            for (int i = 0; i < NDB; ++i) o[i] = o[i] * alpha;
        }
        asm volatile("s_waitcnt vmcnt(0)" ::: "memory"); ATT_BAR();
        if (BR_B && zE) { ++t; break; }
    }
    if (BR_B) {
        for (; t < NT - 1 && zE; ++t) {
            if (t + 2 < NT) ATT_DMA_K(t + 2);
            else if (has_next) ATT_DMA_KX(0, ngbase, ngko, nt0);
            ATT_DMA_V(t + 1);
            ATT_QK(S, t + 1);
            asm volatile("s_nop 11" : "+v"(S[0]), "+v"(S[1]));
            const float mxraw = rowmax(S[0], S[1]);
            const float dqt_ = dq + (float)(64 * (((t + 1) + t0) & (NT - 1)));
            const float dmin = fmaxf(fmaxf(dqt_ - 4.f, -(dqt_ + 63.f)), 0.f);
            if (!__all(mxraw - slope2 * dmin < -136.f)) {
                ATT_BIAS(S, t + 1);
                const float mx = rowmax(S[0], S[1]);
                const bool resc = __any(mx > 8.f);
                if (resc) {
                    const float dl = fmaxf(mx, 0.f); mref += dl; const float alpha = __builtin_amdgcn_exp2f(-dl); lrun *= alpha;
#pragma unroll
                    for (int kvb = 0; kvb < 2; ++kvb)
#pragma unroll
                        for (int j = 0; j < 16; ++j) S[kvb][j] -= dl;
#pragma unroll
                    for (int j = 0; j < 16; ++j) cinit[j] = -mref;
#pragma unroll
                    for (int i = 0; i < NDB; ++i) o[i] = o[i] * alpha;
                }
                zE = !resc && __all(mx < -136.f);
                if (!zE) {
#pragma unroll
                    for (int kvb = 0; kvb < 2; ++kvb)
#pragma unroll
                        for (int j = 0; j < 16; ++j) E[kvb][j] = __builtin_amdgcn_exp2f(S[kvb][j]);
                }
            }
            asm volatile("s_waitcnt vmcnt(0)" ::: "memory"); ATT_BAR();
        }
    }
    }
    const bf16_t* grow = P + (seqrow0 + q0 + wq * 32 + r) * DIN + ocol + 8 * h;
    u32x4 gq[NDB][2];
    if (!BR_B || grp == 0) {
#pragma unroll
        for (int db = 0; db < NDB; ++db)
#pragma unroll
            for (int gp = 0; gp < 2; ++gp) gq[db][gp] = *(const u32x4*)(grow + 32 * db + 16 * gp);
    }
    if (has_next) {
        ATT_DMA_KX(1, ngbase, ngko, nt0); ATT_DMA_VX(0, ngbase, ngvo, nt0);
        const int nqcol = BR_B ? (C_QB + nhead * 128 + grp * 64) : (C_QA + nhead * 64);
        const bf16_t* qp = P + ((size_t)nb * SEQ + nq0 + wq * 32 + r) * DIN + nqcol + 8 * h;
#pragma unroll
        for (int d0 = 0; d0 < 4; ++d0) qf[d0] = *(const bf16x8*)(qp + 16 * d0);
    }
    {
        const ALAS unsigned char* vb = lds + ((NT - 1) & 1) * VBYTES + voff;
        if (!(BR_B && zE)) { ATT_SUMPACK(); ATT_VRD(0, vb); ATT_PV(vb); }
    }
    ATT_BAR();
#undef ATT_BAR
#undef ATT_QK
#undef ATT_BIAS
#undef ATT_SUMPACK
#undef ATT_VRD
#undef ATT_PV
#undef ATT_DMA_K
#undef ATT_DMA_V
#undef ATT_DMA_KX
#undef ATT_DMA_VX
    const float inv = __builtin_amdgcn_rcpf(swap_add(lrun));
    bf16_t* orow = OUTP + (seqrow0 + q0 + wq * 32 + r) * (size_t)opitch + (ocol - (BR_B ? C_GB : C_GA)) + ocol_base + 8 * h;
    if (!BR_B) {
#pragma unroll
        for (int db = 0; db < NDB; ++db)
#pragma unroll
            for (int gp = 0; gp < 2; ++gp) { const u32x4 G = gq[db][gp]; const int g0 = 2 * gp, g1 = 2 * gp + 1;
                const auto r1 = __builtin_amdgcn_permlane32_swap(G.x, G.z, false, false), r2 = __builtin_amdgcn_permlane32_swap(G.y, G.w, false, false);
                u32x2 a, b;
                a.x = cvtpk(o[db][4 * g0] * inv * bf_lo(r1[0]), o[db][4 * g0 + 1] * inv * bf_hi(r1[0])); a.y = cvtpk(o[db][4 * g0 + 2] * inv * bf_lo(r2[0]), o[db][4 * g0 + 3] * inv * bf_hi(r2[0]));
                b.x = cvtpk(o[db][4 * g1] * inv * bf_lo(r1[1]), o[db][4 * g1 + 1] * inv * bf_hi(r1[1])); b.y = cvtpk(o[db][4 * g1 + 2] * inv * bf_lo(r2[1]), o[db][4 * g1 + 3] * inv * bf_hi(r2[1]));
                const auto s1 = __builtin_amdgcn_permlane32_swap(a.x, b.x, false, false), s2 = __builtin_amdgcn_permlane32_swap(a.y, b.y, false, false);
                *(u32x4*)(orow + 32 * db + 16 * gp) = (u32x4){s1[0], s2[0], s1[1], s2[1]}; }
        __syncthreads();
    } else {
        ALAS float* ex = (ALAS float*)(lds + 2 * BUF) + wq * 4096 + lane;
        if (grp == 1) {
#pragma unroll
            for (int db = 0; db < NDB; ++db)
#pragma unroll
                for (int j = 0; j < 16; ++j) ex[(db * 16 + j) * 64] = o[db][j] * inv;
        }
        __syncthreads();
        if (grp == 0) {
            float ss = 0.f;
#pragma unroll
            for (int db = 0; db < NDB; ++db)
#pragma unroll
                for (int j = 0; j < 16; ++j) { const float v = o[db][j] * inv - lam * ex[(db * 16 + j) * 64]; o[db][j] = v; ss += v * v; }
            ss = swap_add(ss);
            const float rs = __builtin_amdgcn_rsqf(ss * (1.f / 128.f) + EPS) * (1.f - LAM_INIT);
#pragma unroll
            for (int db = 0; db < NDB; ++db)
#pragma unroll
                for (int gp = 0; gp < 2; ++gp) { const u32x4 G = gq[db][gp]; const int g0 = 2 * gp, g1 = 2 * gp + 1;
                    const f32x4 sg0 = *(const f32x4*)(subg + 32 * db + 8 * g0 + 4 * h), sg1 = *(const f32x4*)(subg + 32 * db + 8 * g1 + 4 * h);
                    const auto r1 = __builtin_amdgcn_permlane32_swap(G.x, G.z, false, false), r2 = __builtin_amdgcn_permlane32_swap(G.y, G.w, false, false);
                    u32x2 a, b;
                    a.x = cvtpk(o[db][4 * g0] * rs * sg0[0] * bf_lo(r1[0]), o[db][4 * g0 + 1] * rs * sg0[1] * bf_hi(r1[0])); a.y = cvtpk(o[db][4 * g0 + 2] * rs * sg0[2] * bf_lo(r2[0]), o[db][4 * g0 + 3] * rs * sg0[3] * bf_hi(r2[0]));
                    b.x = cvtpk(o[db][4 * g1] * rs * sg1[0] * bf_lo(r1[1]), o[db][4 * g1 + 1] * rs * sg1[1] * bf_hi(r1[1])); b.y = cvtpk(o[db][4 * g1 + 2] * rs * sg1[2] * bf_lo(r2[1]), o[db][4 * g1 + 3] * rs * sg1[3] * bf_hi(r2[1]));
                    const auto s1 = __builtin_amdgcn_permlane32_swap(a.x, b.x, false, false), s2 = __builtin_amdgcn_permlane32_swap(a.y, b.y, false, false);
                    *(u32x4*)(orow + 32 * db + 16 * gp) = (u32x4){s1[0], s2[0], s1[1], s2[1]}; }
        }
        __syncthreads();
    }
}
}

#define LAS __attribute__((address_space(3)))

#define XB_TMO      128
#define XB_XCNT(j)  (256  + 64 * (j))
#define XB_XSUB(j)  (1280 + 64 * (j))
#define XB_XGEN(j)  (2304 + 64 * (j))
#define XB_TOP      3328
#define XB_TOPGEN   3392
#define XCD_BAR_WORDS 3456
#define XB_SPIN_CAP (1u << 18)

__device__ __forceinline__ unsigned xb_ld(unsigned* p)              { return __hip_atomic_load(p, __ATOMIC_RELAXED, __HIP_MEMORY_SCOPE_AGENT); }
__device__ __forceinline__ unsigned xb_add(unsigned* p, unsigned v) { return __hip_atomic_fetch_add(p, v, __ATOMIC_RELAXED, __HIP_MEMORY_SCOPE_AGENT); }
__device__ __forceinline__ unsigned xb_xcc_id() { return (unsigned)__builtin_amdgcn_s_getreg((3 << 11) | 20) & 0xFu; }
#define XB_SPIN(cond, bar) do { unsigned _sp = 0; while (cond) { __builtin_amdgcn_s_sleep(1); \
    if ((++_sp & 255u) == 0u) { if (xb_ld(&(bar)[XB_TMO])) break; if (_sp > XB_SPIN_CAP) { atomicAdd(&(bar)[XB_TMO], 1u); break; } } } } while (0)

struct XcdBarrier {
    unsigned* bar; unsigned x;
    volatile LAS unsigned* st;
};

__device__ __forceinline__ XcdBarrier xcd_barrier_post(unsigned* bar, volatile LAS unsigned* st) {
    XcdBarrier b; b.bar = bar; b.x = xb_xcc_id(); b.st = st;
    if (threadIdx.x == 0) (void)xb_add(&bar[XB_XCNT(b.x)], 1u);
    return b;
}
__device__ __forceinline__ void xcd_barrier_complete(unsigned* bar, unsigned x, unsigned& nloc, unsigned& nx) {
    const unsigned G = gridDim.x * gridDim.y * gridDim.z;
    unsigned sum, cnt, mine, sp = 0u;
    for (;;) {
        sum = 0u; cnt = 0u; mine = 0u;
#pragma unroll
        for (unsigned j = 0; j < 16; ++j) { const unsigned c = xb_ld(&bar[XB_XCNT(j)]); sum += c; cnt += (c > 0u) ? 1u : 0u; mine = (j == x) ? c : mine; }
        if (sum == G) break;
        __builtin_amdgcn_s_sleep(1);
        if ((++sp & 255u) == 0u) { if (xb_ld(&bar[XB_TMO])) break; if (sp > XB_SPIN_CAP) { atomicAdd(&bar[XB_TMO], 1u); break; } }
    }
    nloc = mine > 0u ? mine : 1u; nx = cnt > 0u ? cnt : 1u;
}

__device__ __forceinline__ void xcd_barrier(const XcdBarrier& b) {
    asm volatile("s_waitcnt vmcnt(0)" ::: "memory");
    __syncthreads();
    if (threadIdx.x == 0) {
        unsigned* bar = b.bar;
        __builtin_amdgcn_s_waitcnt(0);
        unsigned nloc = b.st[0], nx = b.st[1];
        if (nloc == 0u) { xcd_barrier_complete(bar, b.x, nloc, nx); b.st[0] = nloc; b.st[1] = nx; }
        const unsigned old = xb_add(&bar[XB_XSUB(b.x)], 1u);
        const unsigned gen = old / nloc;
        if (old + 1u == (gen + 1u) * nloc) {
            __builtin_amdgcn_fence(__ATOMIC_RELEASE, "agent");
            asm volatile("s_waitcnt vmcnt(0)" ::: "memory");
            const unsigned og = xb_add(&bar[XB_TOP], 1u);
            const unsigned tg = og / nx;
            if (og + 1u == (tg + 1u) * nx) xb_add(&bar[XB_TOPGEN], 1u);
            else XB_SPIN(xb_ld(&bar[XB_TOPGEN]) == tg, bar);
            __builtin_amdgcn_fence(__ATOMIC_ACQUIRE, "agent");
            xb_add(&bar[XB_XGEN(b.x)], 1u);
            asm volatile("s_waitcnt vmcnt(0)" ::: "memory");
        } else {
            XB_SPIN(xb_ld(&bar[XB_XGEN(b.x)]) == gen, bar);
            __builtin_amdgcn_fence(__ATOMIC_ACQUIRE, "agent");
            asm volatile("s_waitcnt vmcnt(0)" ::: "memory");
        }
    }
    __syncthreads();
}

typedef unsigned short bf16;
typedef float f32x4 __attribute__((ext_vector_type(4)));
typedef unsigned v4u __attribute__((ext_vector_type(4)));
typedef unsigned u32x2_t __attribute__((ext_vector_type(2)));
__device__ __forceinline__ unsigned f2bf(float f) { unsigned u = __builtin_bit_cast(unsigned, f); return (u + 0x7fffu + ((u >> 16) & 1u)) >> 16; }
__device__ __forceinline__ unsigned pk2(float lo, float hi) { return f2bf(lo) | (f2bf(hi) << 16); }
__device__ __forceinline__ float wave_sum(float v) {
#pragma unroll
    for (int o = 1; o < 64; o <<= 1) v += __shfl_xor(v, o);
    return v;
}
struct Params {
    const float *x_p, *x_s, *c_p, *c_s, *w_ada, *b_ada, *norm_g, *w_in, *a_q_norm, *a_k_norm, *lq1, *lk1, *lq2, *lk2, *sub_norm, *p_a, *p_b, *w_out, *final_g;
    float* out; unsigned char* ws;
};

__device__ __forceinline__ void transpose_item(const float* W, int K, int N, bf16* WT, int k0, int src_col0, int dst_row0, bool perm, LAS float* scr, int lane) {
#pragma unroll 8
    for (int i = 0; i < 32; ++i) { const int kk = 2 * i + (lane >> 5); scr[kk * 33 + (lane & 31)] = W[(size_t)(k0 + kk) * N + src_col0 + (lane & 31)]; }
    asm volatile("s_waitcnt lgkmcnt(0)" ::: "memory");
    const int c = lane & 7;
#pragma unroll
    for (int j = 0; j < 4; ++j) { const int n = (lane >> 3) + 8 * j; const int sn = perm ? (16 * ((n >> 2) & 1) + 4 * (n >> 3) + (n & 3)) : n; const LAS float* s = scr + (8 * c) * 33 + sn;
        v4u o; o.x = pk2(s[0 * 33], s[1 * 33]); o.y = pk2(s[2 * 33], s[3 * 33]); o.z = pk2(s[4 * 33], s[5 * 33]); o.w = pk2(s[6 * 33], s[7 * 33]);
        *(v4u*)(WT + (size_t)(dst_row0 + n) * K + k0 + 8 * c) = o; }
    asm volatile("s_waitcnt lgkmcnt(0)" ::: "memory");
}

__global__ void __launch_bounds__(NTHREADS, 2) fwd_kernel(Params p) {
    extern __shared__ __attribute__((aligned(16))) unsigned char lds_raw[];
    LAS unsigned char* lds = (LAS unsigned char*)lds_raw;
    cg::grid_group grid = cg::this_grid();
    const int tid = threadIdx.x, lane = tid & 63; const int wave = __builtin_amdgcn_readfirstlane(tid >> 6);
    const int G = gridDim.x, bx = blockIdx.x; const int vcu = (G % 8 == 0) ? (bx % 8) * (G / 8) + bx / 8 : bx;
    bf16* PROJ = (bf16*)(p.ws + WS_PROJ); bf16* WOUT_T = (bf16*)(p.ws + WS_WOUT); float* ADA = (float*)(p.ws + WS_ADA); float* RSS = (float*)(p.ws + WS_RSS);
    unsigned char* ob = (unsigned char*)p.out;
    bf16* H = (bf16*)(ob + DO_H); bf16* WIN_T = (bf16*)(ob + DO_WIN); bf16* PA_T = (bf16*)(ob + DO_PA); bf16* PB_T = (bf16*)(ob + DO_PB);
    const int gw = vcu * NWAVES + wave, NGW = G * NWAVES;
    volatile LAS unsigned* MISC = (volatile LAS unsigned*)(lds + 139264);
    if (tid < 2) MISC[tid] = 0u;
    __syncthreads();
    const XcdBarrier xbar = xcd_barrier_post((unsigned*)(p.ws + WS_BAR), MISC);

    {
        LAS float* cact = (LAS float*)lds;
        LAS float* red = (LAS float*)(lds + 32768);
        for (int task = bx; task < 6 * 24; task += G) {
            const int bg = task / 24, n0 = (task % 24) * 128;
#pragma unroll
            for (int i = 0; i < 16; ++i) { const int idx = tid + 512 * i, bb = bg * 8 + (idx >> 10), k = idx & 1023;
                const float c = bb < NB_P ? p.c_p[(size_t)bb * D + k] : p.c_s[(size_t)(bb - NB_P) * D + k]; cact[idx] = c * sigmoidf_(c); }
            __syncthreads();
            const int ch = wave & 1, kq = wave >> 1, n = n0 + 64 * ch + lane;
            float acc[8];
#pragma unroll
            for (int i = 0; i < 8; ++i) acc[i] = 0.f;
            for (int k = kq * 256; k < kq * 256 + 256; k += 4) {
                float wv[4];
#pragma unroll
                for (int j = 0; j < 4; ++j) wv[j] = p.w_ada[(size_t)(k + j) * (3 * D) + n];
#pragma unroll
                for (int i = 0; i < 8; ++i) { const f32x4 cv = *(const LAS f32x4*)(cact + i * 1024 + k); acc[i] += cv[0] * wv[0] + cv[1] * wv[1] + cv[2] * wv[2] + cv[3] * wv[3]; }
            }
#pragma unroll
            for (int i = 0; i < 8; ++i) red[(kq * 8 + i) * 128 + 64 * ch + lane] = acc[i];
            __syncthreads();
#pragma unroll
            for (int i = 0; i < 2; ++i) { const int idx = tid + 512 * i, bb = idx >> 7, nn = idx & 127;
                const float s = (red[(0 * 8 + bb) * 128 + nn] + red[(1 * 8 + bb) * 128 + nn]) + (red[(2 * 8 + bb) * 128 + nn] + red[(3 * 8 + bb) * 128 + nn]);
                ADA[(size_t)(bg * 8 + bb) * (3 * D) + n0 + nn] = s + p.b_ada[n0 + nn]; }
            __syncthreads();
        }
        LAS float* scr = (LAS float*)(lds + wave * 16384);
        constexpr int I_IN = (DIN / 32) * (D / 64), I_PA = (D / 32) * (512 / 64), I_WO = (D / 32) * (D / 64), NITEMS = I_IN + 2 * I_PA + I_WO;
        for (int it = gw; it < NITEMS; it += NGW) {
            int rr = it;
            if (rr < I_IN) { const int g = rr / (D / 64), kb = rr % (D / 64); const int tile = g >> 3, bj = (g & 7) >> 2, wc = g & 3;
                int src; bool perm = false;
                if (tile < 2 || (tile == 2 && wc < 2)) { src = tile * 256 + 64 * wc + 32 * bj; perm = true; }
                else if (tile == 2) src = C_VA + (wc - 2) * 64 + 32 * bj;
                else src = 32 * g;
                transpose_item(p.w_in, D, DIN, WIN_T, 64 * kb, src, 32 * g, perm, scr, lane); continue; }
            rr -= I_IN;
            if (rr < I_PA) { const int g = rr / 8, kb = rr % 8; transpose_item(p.p_a, 512, D, PA_T, 64 * kb, 32 * g, 32 * g, false, scr, lane); continue; }
            rr -= I_PA;
            if (rr < I_PA) { const int g = rr / 8, kb = rr % 8; transpose_item(p.p_b, 512, D, PB_T, 64 * kb, 32 * g, 32 * g, false, scr, lane); continue; }
            rr -= I_PA;
            { const int g = rr / 16, kb = rr % 16; transpose_item(p.w_out, D, D, WOUT_T, 64 * kb, 32 * g, 32 * g, false, scr, lane); }
        }
    }
    grid.sync();

    for (int m0 = gw; m0 < M; m0 += 4 * NGW) {
        int mr[4]; const float* xr[4];
#pragma unroll
        for (int r = 0; r < 4; ++r) { mr[r] = (m0 + r * NGW < M) ? m0 + r * NGW : m0; xr[r] = (mr[r] < MP ? p.x_p + (size_t)mr[r] * D : p.x_s + (size_t)(mr[r] - MP) * D) + 4 * lane; }
        f32x4 v[4][4]; float rs[4];
#pragma unroll
        for (int j = 0; j < 4; ++j) {
#pragma unroll
            for (int r = 0; r < 4; ++r) v[r][j] = __builtin_nontemporal_load((const f32x4*)(xr[r] + 256 * j)); }
#pragma unroll
        for (int r = 0; r < 4; ++r) { float s = 0.f;
#pragma unroll
            for (int j = 0; j < 4; ++j) s += (v[r][j][0] * v[r][j][0] + v[r][j][1] * v[r][j][1]) + (v[r][j][2] * v[r][j][2] + v[r][j][3] * v[r][j][3]);
            rs[r] = __builtin_amdgcn_rsqf(wave_sum(s) * (1.f / D) + EPS); }
#pragma unroll
        for (int j = 0; j < 4; ++j) { const f32x4 g = *(const f32x4*)(p.norm_g + 4 * lane + 256 * j);
#pragma unroll
            for (int r = 0; r < 4; ++r) { const float* ad = ADA + (size_t)(mr[r] / SEQ) * (3 * D) + 4 * lane;
                const f32x4 h = v[r][j] * rs[r] * g * (*(const f32x4*)(ad + D + 256 * j) + 1.f) + *(const f32x4*)(ad + 256 * j);
                unsigned long long* o = (unsigned long long*)(H + (size_t)mr[r] * D) + lane;
                if (r == 0 || mr[r] != m0) o[64 * j] = (unsigned long long)pk2(h[0], h[1]) | ((unsigned long long)pk2(h[2], h[3]) << 32); } }
    }
    xcd_barrier(xbar);

    {
        pg8::Gemm g{H, WIN_T, M, DIN, D, D}; pg8::StaticOrder S; S.init(M, DIN, G, bx);
        pg8::EpiInProj E{PROJ, p.a_q_norm, p.a_k_norm};
        for (int rep = 0; rep < P2_REPS; ++rep) pg8::gemm_phase<pg8::EpiInProj, pg8::StaticOrder, true, true>(lds, g, S, E);
    }
    xcd_barrier(xbar);

    {
        float lam;
        { const float a = wave_sum(p.lq1[lane] * p.lk1[lane]), b2 = wave_sum(p.lq2[lane] * p.lk2[lane]); lam = __builtin_amdgcn_exp2f(a * LOG2E) - __builtin_amdgcn_exp2f(b2 * LOG2E) + LAM_INIT; }
        for (int rep = 0; rep < ATT_REPS; ++rep) {
        const bool real = (rep == ATT_REPS - 1);
        bf16* OUTP_ = real ? PROJ : H; const int OPITCH_ = real ? DIN : D; const int OCA_ = real ? C_GA : 0; const int OCB_ = real ? C_GB : 512;
        if (G == 256) {
            const int xcd = bx & 7, j = bx >> 3;
            att::bf16x8 qfc[4];
            for (int i = 0; i < 12; ++i) { const int pair = 12 * xcd + i, np = pair + 1; att::attn_unit<false>(lds, PROJ, pair >> 1, (pair & 1) * 4 + (j >> 3), j & 7, 0.f, nullptr, OUTP_, OPITCH_, OCA_,
                qfc, i == 0, i + 1 < 12, np >> 1, (np & 1) * 4 + (j >> 3), j & 7); }
            for (int i = 0; i < 12; ++i) {
                const int pp = 2 * i + (j >> 4), bl = pp >> 2, hd = ((pp & 3) + bl) & 3, pn = pp + 2, bln = pn >> 2, hdn = ((pn & 3) + bln) & 3;
                const int qbi = ((j & 15) + 5 * i) & 15, qbn = ((j & 15) + 5 * (i + 1)) & 15;
                att::attn_unit<true>(lds, PROJ, 6 * xcd + bl, hd, qbi, lam, p.sub_norm, OUTP_, OPITCH_, OCB_, qfc, i == 0, i + 1 < 12, 6 * xcd + bln, hdn, qbn); }
        } else {
            const int nA = NB * 8 * 8, nB = NB * 4 * 16;
            for (int u = bx; u < nA + nB; u += G) {
                att::bf16x8 qfg[4];
                if (u < nA) att::attn_unit<false>(lds, PROJ, u >> 6, (u >> 3) & 7, u & 7, 0.f, nullptr, OUTP_, OPITCH_, OCA_, qfg, true, false, 0, 0, 0);
                else { const int v = u - nA; att::attn_unit<true>(lds, PROJ, v >> 6, (v >> 4) & 3, v & 15, lam, p.sub_norm, OUTP_, OPITCH_, OCB_, qfg, true, false, 0, 0, 0); }
            }
        }
        }
    }
    xcd_barrier(xbar);

    {
        pg8::StaticOrder S; S.init(M, D, G, bx);
        { pg8::Gemm g{PROJ + C_GA, PA_T, M, D, 512, DIN}; pg8::EpiMerge<0> E{PROJ}; pg8::gemm_phase<pg8::EpiMerge<0>, pg8::StaticOrder, true, true>(lds, g, S, E); }
        { pg8::Gemm g{PROJ + C_GB, PB_T, M, D, 512, DIN}; pg8::EpiMerge<1> E{PROJ}; pg8::gemm_phase<pg8::EpiMerge<1>, pg8::StaticOrder, true, true>(lds, g, S, E); }
    }
    xcd_barrier(xbar);

    {
        pg8::Gemm g{PROJ + C_MERGED, WOUT_T, M, D, D, DIN}; pg8::StaticOrder S; S.init(M, D, G, bx);
        pg8::EpiOut E{p.x_p, p.x_s, ADA, PROJ, RSS};
        pg8::gemm_phase<pg8::EpiOut, pg8::StaticOrder, true, true>(lds, g, S, E);
    }
    xcd_barrier(xbar);

    for (int m0 = gw; m0 < M; m0 += 2 * NGW) {
        const int m1 = (m0 + NGW < M) ? m0 + NGW : m0;
        float s0 = RSS[(size_t)m0 * 16 + (lane & 15)], s1 = RSS[(size_t)m1 * 16 + (lane & 15)];
        const bf16* yr0 = PROJ + (size_t)m0 * DIN + 4 * lane; const bf16* yr1 = PROJ + (size_t)m1 * DIN + 4 * lane;
        u32x2_t y0[4], y1[4];
#pragma unroll
        for (int j = 0; j < 4; ++j) { y0[j] = __builtin_nontemporal_load((const u32x2_t*)(yr0 + 256 * j)); y1[j] = __builtin_nontemporal_load((const u32x2_t*)(yr1 + 256 * j)); }
        s0 += __shfl_xor(s0, 1); s0 += __shfl_xor(s0, 2); s0 += __shfl_xor(s0, 4); s0 += __shfl_xor(s0, 8);
        s1 += __shfl_xor(s1, 1); s1 += __shfl_xor(s1, 2); s1 += __shfl_xor(s1, 4); s1 += __shfl_xor(s1, 8);
        const float rs0 = __builtin_amdgcn_rsqf(s0 * (1.f / D) + EPS), rs1 = __builtin_amdgcn_rsqf(s1 * (1.f / D) + EPS);
        float* o0 = p.out + (size_t)m0 * D + 4 * lane; float* o1 = p.out + (size_t)m1 * D + 4 * lane;
#pragma unroll
        for (int j = 0; j < 4; ++j) { const f32x4 g = *(const f32x4*)(p.final_g + 4 * lane + 256 * j);
            const f32x4 a0 = {bf_lo(y0[j].x), bf_hi(y0[j].x), bf_lo(y0[j].y), bf_hi(y0[j].y)}, a1 = {bf_lo(y1[j].x), bf_hi(y1[j].x), bf_lo(y1[j].y), bf_hi(y1[j].y)};
            __builtin_nontemporal_store(a0 * rs0 * g, (f32x4*)(o0 + 256 * j));
            if (m1 != m0) __builtin_nontemporal_store(a1 * rs1 * g, (f32x4*)(o1 + 256 * j)); }
    }
}

extern "C" void kernel_launch(void* const* d_in, const int* in_sizes, int n_in, void* d_out, int out_size, void* d_ws, size_t ws_size, hipStream_t stream) {
    static int grid = 0;
    if (grid == 0) {
        if (n_in != 19 || out_size != M * D || ws_size < WS_END) { fprintf(stderr, "kernel_launch: unexpected sizes n_in %d out %d ws %zu\n", n_in, out_size, ws_size); grid = -1; return; }
        int dev = 0, cus = 0, per_cu = 0;
        hipGetDevice(&dev); hipDeviceGetAttribute(&cus, hipDeviceAttributeMultiprocessorCount, dev);
        hipFuncSetAttribute((const void*)fwd_kernel, hipFuncAttributeMaxDynamicSharedMemorySize, LDS_BYTES);
        hipOccupancyMaxActiveBlocksPerMultiprocessor(&per_cu, (const void*)fwd_kernel, NTHREADS, LDS_BYTES);
        if (per_cu < 1) { fprintf(stderr, "kernel_launch: occupancy query says %d blocks per CU\n", per_cu); per_cu = 1; }
        (void)hipGetLastError();
        grid = cus;
    }
    if (grid < 0) return;
    if (hipMemsetAsync((char*)d_ws + WS_BAR, 0, 16384, stream) != hipSuccess) { fprintf(stderr, "kernel_launch: hipMemsetAsync failed\n"); return; }
    Params p{};
    p.x_p = (const float*)d_in[0]; p.x_s = (const float*)d_in[1]; p.c_p = (const float*)d_in[2]; p.c_s = (const float*)d_in[3]; p.w_ada = (const float*)d_in[4]; p.b_ada = (const float*)d_in[5];
    p.norm_g = (const float*)d_in[6]; p.w_in = (const float*)d_in[7]; p.a_q_norm = (const float*)d_in[8]; p.a_k_norm = (const float*)d_in[9]; p.lq1 = (const float*)d_in[10]; p.lk1 = (const float*)d_in[11];
    p.lq2 = (const float*)d_in[12]; p.lk2 = (const float*)d_in[13]; p.sub_norm = (const float*)d_in[14]; p.p_a = (const float*)d_in[15]; p.p_b = (const float*)d_in[16]; p.w_out = (const float*)d_in[17]; p.final_g = (const float*)d_in[18];
    p.out = (float*)d_out; p.ws = (unsigned char*)d_ws;
    void* args[] = {&p};
    hipError_t e = hipLaunchCooperativeKernel((const void*)fwd_kernel, dim3(grid), dim3(NTHREADS), args, LDS_BYTES, stream);
    if (e != hipSuccess) fprintf(stderr, "cooperative launch failed: %s (grid %d)\n", hipGetErrorString(e), grid);
}
```

```cpp
#include <hip/hip_runtime.h>
#include <hip/hip_cooperative_groups.h>
#include <cstdio>
#include <cstdint>
namespace cg = cooperative_groups;
#ifndef ATT_REPS
#define ATT_REPS 1
#endif
#ifndef P2_REPS
#define P2_REPS 1
#endif

constexpr int D = 1024, SEQ = 2048, NB_P = 32, NB_S = 16, NB = NB_P + NB_S, M = NB * SEQ, MP = NB_P * SEQ, DIN = 5376;
constexpr int C_QA = 0, C_KA = 512, C_VA = 640, C_GA = 768, C_QB = 1280, C_KB = 1792, C_VB = 2304, C_GB = 2816, C_MA = 3328, C_MB = 4352, C_MERGED = 1280;
constexpr float EPS = 1e-6f, LOG2E = 1.4426950408889634f, QSCALE = 0.125f * LOG2E, LAM_INIT = 0.2f;
constexpr size_t MiB = 1u << 20;
constexpr size_t WS_PROJ = 0, WS_WOUT = 1008 * MiB, WS_ADA = 1010 * MiB, WS_RSS = 1011 * MiB, WS_BAR = 1017 * MiB, WS_END = 1018 * MiB;
static_assert((size_t)M * DIN * 2 == 1008 * MiB, "proj size");
constexpr size_t DO_H = 0, DO_WIN = 192 * MiB, DO_PA = 203 * MiB, DO_PB = 204 * MiB;
constexpr int NWAVES = 8, NTHREADS = 512, LDS_BYTES = 147456;

typedef unsigned short bf16_t;
__device__ __forceinline__ float bf_lo(unsigned w) { return __builtin_bit_cast(float, w << 16); }
__device__ __forceinline__ float bf_hi(unsigned w) { return __builtin_bit_cast(float, w & 0xffff0000u); }
__device__ __forceinline__ float sigmoidf_(float v) { return __builtin_amdgcn_rcpf(1.f + __builtin_amdgcn_exp2f(-v * LOG2E)); }

namespace pg8 {
#define PG8_LAS __attribute__((address_space(3)))
typedef short bf16x8 __attribute__((ext_vector_type(8)));
typedef float f32x4 __attribute__((ext_vector_type(4)));
typedef unsigned u32x4 __attribute__((ext_vector_type(4)));
constexpr int BM = 256, BK = 64, HALF = 128, HTB = HALF * BK * 2  , STAGE_BYTES = 8 * HTB, NXCD = 8, WGM = 8;

__host__ __device__ __forceinline__ int lds_byte(int r, int c) { const int st = (r >> 4) * 2 + (c >> 5), rr = r & 15, cc = c & 31, ob = rr * 64 + cc * 2; return st * 1024 + (ob ^ (((ob >> 9) & 1) << 5)); }
__host__ __device__ __forceinline__ void stage_rc(int b, int& R, int& C) { const int st = b / 1024, sb = b % 1024, swz = sb ^ (((sb >> 9) & 1) << 5); R = (st >> 1) * 16 + swz / 64; C = (st & 1) * 32 + (swz % 64) / 2; }
__host__ __device__ __forceinline__ int perm32(int rho) { const int n = rho >> 4, i = rho & 15; return 8 * (i >> 2) + 4 * n + (i & 3); }

struct Unit { int pm, pn; };
struct Gemm { const bf16_t* A; const bf16_t* Bt; int M, N, K, lda; };

struct StaticOrder {
    int nM, nN, nwg, G, c;
    __host__ __device__ void init(int M, int N, int G_, int c_) { nM = M / BM; nN = N / BM; nwg = nM * nN; G = G_; c = c_; }
    __host__ __device__ bool next(int i, Unit& u) const {
        const long L = (long)i * G + c; if (L >= nwg) return false;
        int wgid = (int)L; { const int q = nwg / NXCD, r = nwg % NXCD, xcd = wgid % NXCD, off = wgid / NXCD; wgid = (xcd < r ? xcd * (q + 1) : r * (q + 1) + (xcd - r) * q) + off; }
        const int nig = WGM * nN, gid = wgid / nig, fm = gid * WGM, gsz = (nM - fm) < WGM ? (nM - fm) : WGM;
        u.pm = fm + ((wgid % nig) % gsz); u.pn = (wgid % nig) / gsz; return true;
    }
    __device__ __forceinline__ void a_ready(const Unit&) const {}
    __device__ __forceinline__ void done(const Unit&) const {}
};

__device__ __forceinline__ unsigned cvt_pk_bf16(float lo, float hi) { unsigned r; asm volatile("v_cvt_pk_bf16_f32 %0, %1, %2" : "=v"(r) : "v"(lo), "v"(hi)); return r; }

typedef unsigned u32x2 __attribute__((ext_vector_type(2)));

struct EpiInProj {
    static constexpr bool PERM = true, AFTER_DRAIN = false;
    bf16_t* P; const float* gq; const float* gk;
    __device__ __forceinline__ void operator()(const f32x4 (&acc)[2][2][4][2], const Unit& u, int wr, int wc, int fr_in, int fq_in) const {
        int fr = fr_in, fq = fq_in; asm volatile("" : "+v"(fr), "+v"(fq));
        const int row0 = u.pm * BM + wr * 64 + fr; const int pn = u.pn;
        if (pn < 2 || (pn == 2 && wc < 2)) {
            const bool isq = pn < 2; const float* gs = isq ? gq : gk;
            f32x4 gv[2][2];
#pragma unroll
            for (int bj = 0; bj < 2; ++bj)
#pragma unroll
                for (int n = 0; n < 2; ++n) gv[bj][n] = *(const f32x4*)(gs + 32 * bj + 16 * n + 4 * fq);
            float invf[4];
#pragma unroll
            for (int e = 0; e < 4; ++e) invf[e] = __builtin_amdgcn_exp2f(-(float)(4 * fq + e) * 0.8304820237f) * 0.15915494309f;
            const float qs = isq ? QSCALE : 1.f; const int cbase = (isq ? pn * 256 : C_KA) + 64 * wc;
#pragma unroll
            for (int ai = 0; ai < 2; ++ai)
#pragma unroll
                for (int m = 0; m < 4; ++m) {
                    const int row = row0 + ai * HALF + m * 16; const int t = row & (SEQ - 1);
                    float ss = 0.f;
#pragma unroll
                    for (int bj = 0; bj < 2; ++bj)
#pragma unroll
                        for (int n = 0; n < 2; ++n) { const f32x4 v = acc[ai][bj][m][n]; ss += (v[0] * v[0] + v[1] * v[1]) + (v[2] * v[2] + v[3] * v[3]); }
                    ss += __shfl_xor(ss, 16); ss += __shfl_xor(ss, 32);
                    const float rs = __builtin_amdgcn_rsqf(ss * (1.f / 64.f) + EPS);
                    bf16_t* rowp = P + (size_t)row * DIN + cbase + 4 * fq;
#pragma unroll
                    for (int bj = 0; bj < 2; ++bj) {
                        const float pos = (float)(bj == 0 ? (t >> 6) : (t & 63));
                        const f32x4 x1 = acc[ai][bj][m][0] * rs * gv[bj][0], x2 = acc[ai][bj][m][1] * rs * gv[bj][1];
                        f32x4 o1, o2;
#pragma unroll
                        for (int e = 0; e < 4; ++e) { const float a = pos * invf[e]; const float c = __builtin_amdgcn_cosf(a), s = __builtin_amdgcn_sinf(a);
                            o1[e] = (x1[e] * c - x2[e] * s) * qs; o2[e] = (x2[e] * c + x1[e] * s) * qs; }
                        u32x2 w1, w2; w1.x = cvt_pk_bf16(o1[0], o1[1]); w1.y = cvt_pk_bf16(o1[2], o1[3]); w2.x = cvt_pk_bf16(o2[0], o2[1]); w2.y = cvt_pk_bf16(o2[2], o2[3]);
                        *(u32x2*)(rowp + 32 * bj) = w1; *(u32x2*)(rowp + 32 * bj + 16) = w2;
                    }
                }
        } else {
            int cb; int act;
            if (pn == 2) { cb = C_VA + (wc - 2) * 64 + 8 * fq; act = 0; }
            else { cb = pn * 256 + wc * 32 + 8 * fq; act = (pn <= 4 || pn == 11 || pn == 12) ? 1 : (pn >= 13 ? 2 : (pn <= 6 ? 3 : 0)); }
            const int bjs = (pn == 2) ? 32 : HALF;
#pragma unroll
            for (int ai = 0; ai < 2; ++ai)
#pragma unroll
                for (int m = 0; m < 4; ++m) { bf16_t* rowp = P + (size_t)(row0 + ai * HALF + m * 16) * DIN + cb;
#pragma unroll
                    for (int bj = 0; bj < 2; ++bj) { f32x4 v0 = acc[ai][bj][m][0], v1 = acc[ai][bj][m][1];
                        if (act == 1) {
#pragma unroll
                            for (int e = 0; e < 4; ++e) { v0[e] = v0[e] * sigmoidf_(v0[e]); v1[e] = v1[e] * sigmoidf_(v1[e]); }
                        } else if (act == 2) {
#pragma unroll
                            for (int e = 0; e < 4; ++e) { v0[e] = sigmoidf_(v0[e]); v1[e] = sigmoidf_(v1[e]); }
                        } else if (act == 3) { v0 = v0 * QSCALE; v1 = v1 * QSCALE; }
                        u32x4 w; w.x = cvt_pk_bf16(v0[0], v0[1]); w.y = cvt_pk_bf16(v0[2], v0[3]); w.z = cvt_pk_bf16(v1[0], v1[1]); w.w = cvt_pk_bf16(v1[2], v1[3]);
                        *(u32x4*)(rowp + bj * bjs) = w; } }
        }
    }
};
template <int MODE> struct EpiMerge {
    static constexpr bool PERM = true, AFTER_DRAIN = false;
    bf16_t* P;
    __device__ __forceinline__ void operator()(const f32x4 (&acc)[2][2][4][2], const Unit& u, int wr, int wc, int fr_in, int fq_in) const {
        int fr = fr_in, fq = fq_in; asm volatile("" : "+v"(fr), "+v"(fq));
        const int row0 = u.pm * BM + wr * 64 + fr; const int col0 = u.pn * BM + wc * 32 + 8 * fq;
#pragma unroll
        for (int ai = 0; ai < 2; ++ai)
#pragma unroll
            for (int m = 0; m < 4; ++m) { bf16_t* rowp = P + (size_t)(row0 + ai * HALF + m * 16) * DIN + col0;
#pragma unroll
                for (int bj = 0; bj < 2; ++bj) { const f32x4 v0 = acc[ai][bj][m][0], v1 = acc[ai][bj][m][1];
                    const u32x4 s = *(const u32x4*)(rowp + C_MA + bj * HALF);
                    float o[8];
                    if (MODE == 0) {
                        o[0] = bf_lo(s.x) * v0[0]; o[1] = bf_hi(s.x) * v0[1]; o[2] = bf_lo(s.y) * v0[2]; o[3] = bf_hi(s.y) * v0[3];
                        o[4] = bf_lo(s.z) * v1[0]; o[5] = bf_hi(s.z) * v1[1]; o[6] = bf_lo(s.w) * v1[2]; o[7] = bf_hi(s.w) * v1[3];
                    } else {
                        const u32x4 g = *(const u32x4*)(rowp + C_MB + bj * HALF);
                        o[0] = bf_lo(s.x) + bf_lo(g.x) * v0[0]; o[1] = bf_hi(s.x) + bf_hi(g.x) * v0[1]; o[2] = bf_lo(s.y) + bf_lo(g.y) * v0[2]; o[3] = bf_hi(s.y) + bf_hi(g.y) * v0[3];
                        o[4] = bf_lo(s.z) + bf_lo(g.z) * v1[0]; o[5] = bf_hi(s.z) + bf_hi(g.z) * v1[1]; o[6] = bf_lo(s.w) + bf_lo(g.w) * v1[2]; o[7] = bf_hi(s.w) + bf_hi(g.w) * v1[3];
                    }
                    u32x4 w; w.x = cvt_pk_bf16(o[0], o[1]); w.y = cvt_pk_bf16(o[2], o[3]); w.z = cvt_pk_bf16(o[4], o[5]); w.w = cvt_pk_bf16(o[6], o[7]);
                    *(u32x4*)(rowp + (MODE == 0 ? C_MA : C_MERGED) + bj * HALF) = w; } }
    }
};
struct EpiOut {
    static constexpr bool PERM = true, AFTER_DRAIN = false;
    const float* xp; const float* xs; const float* ada; bf16_t* yb; float* rss;
    __device__ __forceinline__ void operator()(const f32x4 (&acc)[2][2][4][2], const Unit& u, int wr, int wc, int fr_in, int fq_in) const {
        int fr = fr_in, fq = fq_in; asm volatile("" : "+v"(fr), "+v"(fq));
        const int row0 = u.pm * BM + wr * 64 + fr; const int col0 = u.pn * BM + wc * 32 + 8 * fq;
        const int tile_row = u.pm * BM; const float* xb = tile_row < MP ? xp + (size_t)tile_row * D : xs + (size_t)(tile_row - MP) * D;
        const float* gp = ada + (size_t)(tile_row / SEQ) * (3 * D) + 2 * D + col0;
        f32x4 gv[2][2];
#pragma unroll
        for (int bj = 0; bj < 2; ++bj)
#pragma unroll
            for (int n = 0; n < 2; ++n) gv[bj][n] = *(const f32x4*)(gp + bj * HALF + 4 * n);
#pragma unroll
        for (int ai = 0; ai < 2; ++ai)
#pragma unroll
            for (int m = 0; m < 4; ++m) { const int rl = wr * 64 + fr + ai * HALF + m * 16; const size_t off = (size_t)rl * D + col0; float ss = 0.f;
#pragma unroll
                for (int bj = 0; bj < 2; ++bj) { f32x4 y[2];
#pragma unroll
                    for (int n = 0; n < 2; ++n) { const f32x4 xv = *(const f32x4*)(xb + off + bj * HALF + 4 * n); y[n] = xv + gv[bj][n] * acc[ai][bj][m][n];
                        ss += (y[n][0] * y[n][0] + y[n][1] * y[n][1]) + (y[n][2] * y[n][2] + y[n][3] * y[n][3]); }
                    u32x4 w; w.x = cvt_pk_bf16(y[0][0], y[0][1]); w.y = cvt_pk_bf16(y[0][2], y[0][3]); w.z = cvt_pk_bf16(y[1][0], y[1][1]); w.w = cvt_pk_bf16(y[1][2], y[1][3]);
                    *(u32x4*)(yb + (size_t)(tile_row + rl) * DIN + col0 + bj * HALF) = w; }
                ss += __shfl_xor(ss, 16); ss += __shfl_xor(ss, 32);
                if (fq == 0) rss[(size_t)(tile_row + rl) * 16 + u.pn * 4 + wc] = ss; }
    }
};

template <class Epi, class Sched, bool ALIGN_EPI = false, bool SP2 = false>
__device__ __forceinline__ void gemm_phase(PG8_LAS unsigned char* lds, const Gemm g, const Sched& S, const Epi& E) {
    const int tid = threadIdx.x, wid = __builtin_amdgcn_readfirstlane(tid >> 6), lane = tid & 63, wr = wid >> 2, wc = wid & 3, fr = lane & 15, fq = lane >> 4;
    const int K = g.K, nt = K / BK;
    unsigned voffA[2], voffB[2];
#pragma unroll
    for (int i = 0; i < 2; ++i) { int R, C; stage_rc(tid * 16 + i * 8192, R, C); const int Rb = Epi::PERM ? ((R & ~31) + perm32(R & 31)) : R;
        voffA[i] = (unsigned)(R * g.lda + C) * 2u; voffB[i] = (unsigned)(Rb * K + C) * 2u; }
    const size_t kstep = (size_t)(BK * 2);
    const size_t hstep = (size_t)HALF * K * 2;
    const size_t tstep = 2 * hstep; const size_t hstepA = (size_t)HALF * g.lda * 2, tstepA = 2 * hstepA;
    const unsigned ldsw = (unsigned)wid * 1024u;
    const int aoff = lds_byte(wr * 64 + fr, fq * 8), boff = lds_byte(wc * 32 + fr, fq * 8);
#define PG8_SA(b, h) (((b) * 2 + (h)) * HTB)
#define PG8_SB(b, h) ((4 + (b) * 2 + (h)) * HTB)
#define PG8_STAGE(bufoff, gbase, voff) do { _Pragma("unroll") for (int _i = 0; _i < 2; ++_i) \
        __builtin_amdgcn_global_load_lds((const unsigned*)((const char*)(gbase) + (voff)[_i]), (PG8_LAS unsigned*)(lds + (bufoff) + ldsw + _i * 8192), 16, 0, 0); } while (0)
#define PG8_LDA(dst, b, h) do { _Pragma("unroll") for (int m = 0; m < 4; ++m) _Pragma("unroll") for (int k = 0; k < 2; ++k) dst[m][k] = *(const PG8_LAS bf16x8*)(lds + PG8_SA(b, h) + aoff + m * 2048 + k * 1024); } while (0)
#define PG8_LDB(dst, b, h) do { _Pragma("unroll") for (int n = 0; n < 2; ++n) _Pragma("unroll") for (int k = 0; k < 2; ++k) dst[n][k] = *(const PG8_LAS bf16x8*)(lds + PG8_SB(b, h) + boff + n * 2048 + k * 1024); } while (0)
#define PG8_MMA(ai, bj, At, Bt) do { __builtin_amdgcn_s_setprio(1); _Pragma("unroll") for (int m = 0; m < 4; ++m) _Pragma("unroll") for (int n = 0; n < 2; ++n) _Pragma("unroll") for (int k = 0; k < 2; ++k) \
        acc[ai][bj][m][n] = __builtin_amdgcn_mfma_f32_16x16x32_bf16(Bt[n][k], At[m][k], acc[ai][bj][m][n], 0, 0, 0); __builtin_amdgcn_s_setprio(0); } while (0)
#define PG8_WAIT_V(n) asm volatile("s_waitcnt vmcnt(" #n ")" ::: "memory")
#define PG8_WAIT_L(n) asm volatile("s_waitcnt lgkmcnt(" #n ")" ::: "memory")
#define PG8_BAR __builtin_amdgcn_s_barrier()
#define PG8_SCHED __builtin_amdgcn_sched_barrier(0)
    Unit cur, nxt; int ui = 0;
    if (!S.next(0, cur)) return;
    f32x4 acc[2][2][4][2];
#pragma unroll
    for (int a = 0; a < 2; ++a)
#pragma unroll
        for (int b = 0; b < 2; ++b)
#pragma unroll
            for (int m = 0; m < 4; ++m)
#pragma unroll
                for (int n = 0; n < 2; ++n) acc[a][b][m][n] = (f32x4){0.f, 0.f, 0.f, 0.f};
    bf16x8 At[4][2], B0[2][2], B1[2][2];
    const char* cA = (const char*)g.A + (size_t)cur.pm * tstepA; const char* cB = (const char*)g.Bt + (size_t)cur.pn * tstep;
    S.a_ready(cur);
    if constexpr (SP2) {
        PG8_STAGE(PG8_SB(0, 0), cB, voffB); PG8_STAGE(PG8_SB(0, 1), cB + hstep, voffB); PG8_STAGE(PG8_SA(0, 0), cA, voffA); PG8_STAGE(PG8_SA(0, 1), cA + hstepA, voffA);
        if (wr == 1) PG8_BAR;
        PG8_WAIT_V(2); PG8_BAR;
        PG8_STAGE(PG8_SB(1, 0), cB + kstep, voffB); PG8_STAGE(PG8_SA(1, 0), cA + kstep, voffA); PG8_STAGE(PG8_SB(1, 1), cB + hstep + kstep, voffB);
        PG8_WAIT_V(6); PG8_BAR;
    } else {
        PG8_STAGE(PG8_SB(0, 0), cB, voffB); PG8_STAGE(PG8_SA(0, 0), cA, voffA); PG8_STAGE(PG8_SB(0, 1), cB + hstep, voffB); PG8_STAGE(PG8_SA(0, 1), cA + hstepA, voffA);
        if (wr == 1) PG8_BAR;
        PG8_WAIT_V(4); PG8_BAR;
        PG8_STAGE(PG8_SB(1, 0), cB + kstep, voffB); PG8_STAGE(PG8_SA(1, 0), cA + kstep, voffA); PG8_STAGE(PG8_SB(1, 1), cB + hstep + kstep, voffB);
        PG8_WAIT_V(6); PG8_BAR;
    }
    for (;;) {
        const bool has_next = S.next(ui + 1, nxt);
        const char* nA = has_next ? (const char*)g.A + (size_t)nxt.pm * tstepA : cA; const char* nB = has_next ? (const char*)g.Bt + (size_t)nxt.pn * tstep : cB;
        for (int t = 0; t < nt; t += 2) {
            const bool last = (t == nt - 2);
            const char* a1 = cA + (size_t)(t + 1) * kstep;
            const char* a2 = last ? nA : cA + (size_t)(t + 2) * kstep; const char* b2 = last ? nB : cB + (size_t)(t + 2) * kstep;
            const char* a3 = a2 + kstep; const char* b3 = b2 + kstep;
            if (last && has_next) S.a_ready(nxt);
            if constexpr (SP2) {
            PG8_LDB(B0, 0, 0); PG8_LDB(B1, 0, 1); PG8_SCHED; PG8_LDA(At, 0, 0); PG8_STAGE(PG8_SA(1, 1), a1 + hstepA, voffA);
            PG8_WAIT_V(8); PG8_WAIT_L(0); PG8_BAR; PG8_MMA(0, 0, At, B0); PG8_MMA(0, 1, At, B1); PG8_BAR; PG8_SCHED;
            PG8_LDA(At, 0, 1); PG8_STAGE(PG8_SB(0, 0), b2, voffB); PG8_STAGE(PG8_SB(0, 1), b2 + hstep, voffB); PG8_STAGE(PG8_SA(0, 0), a2, voffA);
            PG8_WAIT_V(8); PG8_WAIT_L(0); PG8_BAR; PG8_MMA(1, 0, At, B0); PG8_MMA(1, 1, At, B1); PG8_BAR; PG8_SCHED;
            PG8_LDB(B0, 1, 0); PG8_LDB(B1, 1, 1); PG8_SCHED; PG8_LDA(At, 1, 0); PG8_STAGE(PG8_SA(0, 1), a2 + hstepA, voffA);
            PG8_WAIT_V(8); PG8_WAIT_L(0); PG8_BAR; PG8_MMA(0, 0, At, B0); PG8_MMA(0, 1, At, B1); PG8_BAR; PG8_SCHED;
            PG8_LDA(At, 1, 1); PG8_STAGE(PG8_SB(1, 0), b3, voffB); PG8_STAGE(PG8_SB(1, 1), b3 + hstep, voffB); PG8_STAGE(PG8_SA(1, 0), a3, voffA);
            PG8_WAIT_V(8); PG8_WAIT_L(0); PG8_BAR; PG8_MMA(1, 0, At, B0); PG8_MMA(1, 1, At, B1); PG8_BAR; PG8_SCHED;
            } else {
            PG8_LDB(B0, 0, 0); PG8_SCHED; PG8_LDA(At, 0, 0); PG8_STAGE(PG8_SA(1, 1), a1 + hstepA, voffA);
            PG8_WAIT_L(8); PG8_BAR; PG8_WAIT_L(0); PG8_MMA(0, 0, At, B0); PG8_BAR; PG8_SCHED;
            PG8_LDB(B1, 0, 1); PG8_STAGE(PG8_SB(0, 0), b2, voffB);
            PG8_BAR; PG8_WAIT_L(0); PG8_MMA(0, 1, At, B1); PG8_BAR;
            PG8_LDA(At, 0, 1); PG8_STAGE(PG8_SA(0, 0), a2, voffA);
            PG8_BAR; PG8_WAIT_L(0); PG8_MMA(1, 0, At, B0); PG8_BAR; PG8_SCHED;
            PG8_STAGE(PG8_SB(0, 1), b2 + hstep, voffB);
            PG8_WAIT_V(6); PG8_BAR; PG8_MMA(1, 1, At, B1); PG8_BAR;
            PG8_LDB(B0, 1, 0); PG8_SCHED; PG8_LDA(At, 1, 0); PG8_STAGE(PG8_SA(0, 1), a2 + hstepA, voffA);
            PG8_WAIT_L(8); PG8_BAR; PG8_WAIT_L(0); PG8_MMA(0, 0, At, B0); PG8_BAR; PG8_SCHED;
            PG8_LDB(B1, 1, 1); PG8_STAGE(PG8_SB(1, 0), b3, voffB);
            PG8_BAR; PG8_WAIT_L(0); PG8_MMA(0, 1, At, B1); PG8_BAR;
            PG8_LDA(At, 1, 1); PG8_STAGE(PG8_SA(1, 0), a3, voffA);
            PG8_BAR; PG8_WAIT_L(0); PG8_MMA(1, 0, At, B0); PG8_BAR; PG8_SCHED;
            PG8_STAGE(PG8_SB(1, 1), b3 + hstep, voffB);
            PG8_WAIT_V(6); PG8_BAR; PG8_MMA(1, 1, At, B1); PG8_BAR;
            }
        }
        if constexpr (ALIGN_EPI) { if (wr == 0) PG8_BAR; }
        if constexpr (!Epi::AFTER_DRAIN) { E(acc, cur, wr, wc, fr, fq); S.done(cur); }
        if (!has_next) break;
#pragma unroll
        for (int a = 0; a < 2; ++a)
#pragma unroll
            for (int b = 0; b < 2; ++b)
#pragma unroll
                for (int m = 0; m < 4; ++m)
#pragma unroll
                    for (int n = 0; n < 2; ++n) acc[a][b][m][n] = (f32x4){0.f, 0.f, 0.f, 0.f};
        cur = nxt; cA = nA; cB = nB; ++ui;
        if constexpr (ALIGN_EPI) { if (wr == 1) PG8_BAR; }
    }
    PG8_WAIT_V(0);
    if constexpr (!ALIGN_EPI) { if (wr == 0) PG8_BAR; }
    PG8_BAR;
    if constexpr (Epi::AFTER_DRAIN) { E.fused(acc, cur, wr, wc, fr, fq, lds, wid, lane); S.done(cur); }
#undef PG8_SA
#undef PG8_SB
#undef PG8_STAGE
#undef PG8_LDA
#undef PG8_LDB
#undef PG8_MMA
#undef PG8_WAIT_V
#undef PG8_WAIT_L
#undef PG8_BAR
#undef PG8_SCHED
}
}

namespace att {
#define ALAS __attribute__((address_space(3)))
typedef unsigned short bf16_t;
typedef short bf16x8 __attribute__((ext_vector_type(8)));
typedef short s16x4 __attribute__((ext_vector_type(4)));
typedef float f32x16 __attribute__((ext_vector_type(16)));
typedef float f32x4 __attribute__((ext_vector_type(4)));
typedef unsigned u32x4 __attribute__((ext_vector_type(4)));
typedef unsigned u32x2 __attribute__((ext_vector_type(2)));
typedef float f32x2_t __attribute__((ext_vector_type(2))); typedef __bf16 bf16x2_t __attribute__((ext_vector_type(2)));
typedef short v4i16_t __attribute__((ext_vector_type(4)));
__device__ __forceinline__ unsigned cvtpk(float lo, float hi) { f32x2_t v = {lo, hi}; bf16x2_t b = __builtin_convertvector(v, bf16x2_t); return __builtin_bit_cast(unsigned, b); }
__device__ __forceinline__ float swap_max(float m) { auto rr = __builtin_amdgcn_permlane32_swap(__float_as_uint(m), __float_as_uint(m), false, false); return fmaxf(__uint_as_float(rr[0]), __uint_as_float(rr[1])); }
__device__ __forceinline__ float swap_add(float m) { auto rr = __builtin_amdgcn_permlane32_swap(__float_as_uint(m), __float_as_uint(m), false, false); return __uint_as_float(rr[0]) + __uint_as_float(rr[1]); }
__device__ __forceinline__ float max3f(float a, float b, float c) { float r; asm("v_max3_f32 %0, %1, %2, %3" : "=v"(r) : "v"(a), "v"(b), "v"(c)); return r; }
__device__ __forceinline__ float max2f(float a, float b) { float r; asm("v_max_f32_e32 %0, %1, %2" : "=v"(r) : "v"(a), "v"(b)); return r; }
__device__ __forceinline__ float rowmax(const f32x16& p0, const f32x16& p1) {
    float a = max3f(p0[0], p0[1], p1[0]), b = max3f(p0[2], p0[3], p1[1]); a = max3f(a, p1[2], p1[3]);
#pragma unroll
    for (int r = 4; r < 16; r += 4) { a = max3f(a, p0[r], p0[r + 1]); b = max3f(b, p0[r + 2], p0[r + 3]); a = max3f(a, p1[r], p1[r + 1]); b = max3f(b, p1[r + 2], p1[r + 3]); }
    const float m = max2f(a, b);
    auto rr = __builtin_amdgcn_permlane32_swap(__float_as_uint(m), __float_as_uint(m), false, false);
    return max2f(__uint_as_float(rr[0]), __uint_as_float(rr[1]));
}
__device__ __forceinline__ void glds16(const void* gsrc, unsigned lds_dst) { unsigned keep;
    asm volatile("s_mov_b32 %0, m0\n\ts_mov_b32 m0, %2\n\ts_nop 0\n\tglobal_load_lds_dwordx4 %1, off\n\ts_mov_b32 m0, %0" : "=&s"(keep) : "v"(gsrc), "s"(lds_dst) : "memory"); }
__device__ __forceinline__ s16x4 vtr(const ALAS unsigned char* p) { return __builtin_bit_cast(s16x4, __builtin_amdgcn_ds_read_tr16_b64_v4i16((ALAS v4i16_t*)p)); }

template <bool BR_B>
__device__ __forceinline__ void attn_unit(ALAS unsigned char* lds, bf16_t* P, int b, int head, int qb, float lam, const float* subg, bf16_t* OUTP, int opitch, int ocol_base,
                                          bf16x8 (&qf)[4], bool first, bool has_next, int nb, int nhead, int nqb) {
    constexpr int DV = BR_B ? 128 : 64, NDB = DV / 32, KBYTES = 8192, NK = BR_B ? 2 : 1, VBYTES = DV * 64 * 2, BUF = NK * KBYTES + VBYTES, NT = SEQ / 64;
    int tid = threadIdx.x; asm volatile("" : "+v"(tid));
    const int lane = tid & 63, r = lane & 31, h = lane >> 5; const int wave = __builtin_amdgcn_readfirstlane(tid >> 6);
    const int grp = BR_B ? (wave >> 2) : 0, wq = BR_B ? (wave & 3) : wave;
    const size_t seqrow0 = (size_t)b * SEQ;
    const int q0 = BR_B ? qb * 128 : qb * 256;
    const int qcol = BR_B ? (C_QB + head * 128 + grp * 64) : (C_QA + head * 64);
    const int kcol = BR_B ? (C_KB + head * 128) : (C_KA + (head >> 2) * 64);
    const int vcol = BR_B ? (C_VB + head * 128) : (C_VA + (head >> 2) * 64);
    const int ocol = BR_B ? (C_GB + head * 128) : (C_GA + head * 64);
    const unsigned char* gbase = (const unsigned char*)(P + seqrow0 * DIN);
    unsigned gko, gvo;
    { const int row = 8 * wave + (lane >> 3), c = (lane & 7) ^ ((row >> 1) & 7); gko = (unsigned)(row * DIN + kcol + 8 * c) * 2u;
      const int dh = wave >> 2, rg = wave & 3; gvo = (unsigned)((rg * 16 + (lane >> 2)) * DIN + vcol + dh * 32 + (lane & 3) * 8) * 2u; }
    const unsigned lds0 = (unsigned)(uintptr_t)lds + (unsigned)wave * 1024u;
    const int t0 = BR_B ? (q0 >> 6) : 0;
#define ATT_DMA_KX(t, GB, GKO, T0) do { const unsigned char* gb_ = (GB) + (size_t)(((t) + (T0)) & (NT - 1)) * (64 * DIN * 2); const unsigned lb_ = (unsigned)__builtin_amdgcn_readfirstlane(lds0 + (unsigned)(((t) & 1) * NK * KBYTES)); \
        glds16(gb_ + (GKO), lb_); if (BR_B) glds16(gb_ + (GKO) + 128, lb_ + KBYTES); } while (0)
#define ATT_DMA_VX(t, GB, GVO, T0) do { const unsigned char* gb_ = (GB) + (size_t)(((t) + (T0)) & (NT - 1)) * (64 * DIN * 2); const unsigned lb_ = (unsigned)__builtin_amdgcn_readfirstlane(lds0 + (unsigned)(2 * NK * KBYTES + ((t) & 1) * VBYTES)); \
        glds16(gb_ + (GVO), lb_); if (BR_B) glds16(gb_ + (GVO) + 128, lb_ + 8192); } while (0)
#define ATT_DMA_K(t) ATT_DMA_KX(t, gbase, gko, t0)
#define ATT_DMA_V(t) ATT_DMA_VX(t, gbase, gvo, t0)
    if (first) { ATT_DMA_K(0); ATT_DMA_V(0); ATT_DMA_K(1); }
    if (first) { const bf16_t* qp = P + (seqrow0 + q0 + wq * 32 + r) * DIN + qcol + 8 * h;
#pragma unroll
      for (int d0 = 0; d0 < 4; ++d0) qf[d0] = *(const bf16x8*)(qp + 16 * d0); }
    f32x16 o[NDB];
#pragma unroll
    for (int i = 0; i < NDB; ++i)
#pragma unroll
        for (int j = 0; j < 16; ++j) o[i][j] = 0.f;
    float mref = 0.f, lrun = 0.f;
    const int swz = (r >> 1) & 7;
    int koffs[4];
#pragma unroll
    for (int d0 = 0; d0 < 4; ++d0) koffs[d0] = grp * KBYTES + r * 128 + (((2 * d0 + h) ^ swz) << 4);
    const int voff = 2 * NK * KBYTES + ((lane >> 4) & 1) * 32 + (lane & 3) * 8 + (4 * h + ((lane & 15) >> 2)) * 64;
    const float slope2 = BR_B ? __builtin_amdgcn_exp2f(-2.f * (float)(head + 1)) * LOG2E : 0.f;
    float dq = (float)(4 * h - (q0 + wq * 32 + r)); asm volatile("" : "+v"(dq));
    f32x16 cinit;
#pragma unroll
    for (int j = 0; j < 16; ++j) cinit[j] = 0.f;
#define ATT_BAR() asm volatile("s_waitcnt lgkmcnt(0)\n\ts_barrier" ::: "memory")
#define ATT_QK(S, tt) do { const ALAS unsigned char* kb_ = lds + ((tt) & 1) * (NK * KBYTES); \
        _Pragma("unroll") for (int kvb = 0; kvb < 2; ++kvb) { bf16x8 kf[4]; \
            _Pragma("unroll") for (int d0 = 0; d0 < 4; ++d0) kf[d0] = *(const ALAS bf16x8*)(kb_ + kvb * 4096 + koffs[d0]); \
            _Pragma("unroll") for (int d0 = 0; d0 < 4; ++d0) S[kvb] = __builtin_amdgcn_mfma_f32_32x32x16_bf16(kf[d0], qf[d0], d0 == 0 ? cinit : S[kvb], 0, 0, 0); } } while (0)
#define ATT_BIAS(S, tt) do { if (BR_B) { const float dqt = dq + (float)(64 * (((tt) + t0) & (NT - 1))); \
            _Pragma("unroll") for (int kvb = 0; kvb < 2; ++kvb) _Pragma("unroll") for (int j = 0; j < 16; ++j) { const float dd = dqt + (float)(32 * kvb + (j & 3) + 8 * (j >> 2)); S[kvb][j] = __builtin_fmaf(-slope2, __builtin_fabsf(dd), S[kvb][j]); } } \
        else { asm volatile("s_nop 11" : "+v"(S[0]), "+v"(S[1])); } } while (0)
#define ATT_SUMPACK() do { float ls = 0.f; \
        _Pragma("unroll") for (int kvb = 0; kvb < 2; ++kvb) _Pragma("unroll") for (int j = 0; j < 16; ++j) ls += E[kvb][j]; \
        lrun += ls; \
        _Pragma("unroll") for (int kvb = 0; kvb < 2; ++kvb) _Pragma("unroll") for (int s = 0; s < 2; ++s) { u32x4 w; w.x = cvtpk(E[kvb][8 * s], E[kvb][8 * s + 1]); w.y = cvtpk(E[kvb][8 * s + 2], E[kvb][8 * s + 3]); \
                w.z = cvtpk(E[kvb][8 * s + 4], E[kvb][8 * s + 5]); w.w = cvtpk(E[kvb][8 * s + 6], E[kvb][8 * s + 7]); pa[kvb][s] = __builtin_bit_cast(bf16x8, w); } } while (0)
#define ATT_VRD(db, vb_) do { _Pragma("unroll") for (int ks = 0; ks < 4; ++ks) { const ALAS unsigned char* vp = (vb_) + ((db) * 4 + ks) * 1024; vlo[(db) & 1][ks] = vtr(vp); vhi[(db) & 1][ks] = vtr(vp + 512); } } while (0)
#define ATT_PV(vb_) do { _Pragma("unroll") for (int db = 0; db < NDB; ++db) { if (db + 1 < NDB) ATT_VRD(db + 1, vb_); \
            _Pragma("unroll") for (int ks = 0; ks < 4; ++ks) { const bf16x8 vf = __builtin_shufflevector(vlo[db & 1][ks], vhi[db & 1][ks], 0, 1, 2, 3, 4, 5, 6, 7); \
                o[db] = __builtin_amdgcn_mfma_f32_32x32x16_bf16(vf, pa[ks >> 1][ks & 1], o[db], 0, 0, 0); } } } while (0)
    const int nq0 = BR_B ? nqb * 128 : nqb * 256;
    const int nkcol = BR_B ? (C_KB + nhead * 128) : (C_KA + (nhead >> 2) * 64), nvcol = BR_B ? (C_VB + nhead * 128) : (C_VA + (nhead >> 2) * 64);
    const unsigned char* ngbase = (const unsigned char*)(P + (size_t)nb * SEQ * DIN);
    const unsigned ngko = gko + (unsigned)(nkcol - kcol) * 2u, ngvo = gvo + (unsigned)(nvcol - vcol) * 2u; const int nt0 = BR_B ? (nq0 >> 6) : 0;
    asm volatile("s_waitcnt vmcnt(0)" ::: "memory"); ATT_BAR();
    f32x16 E[2], S[2]; bf16x8 pa[2][2]; s16x4 vlo[2][4], vhi[2][4];
    {
        ATT_QK(E, 0); ATT_BIAS(E, 0);
        const float mx = rowmax(E[0], E[1]);
        mref = mx;
#pragma unroll
        for (int j = 0; j < 16; ++j) cinit[j] = -mref;
#pragma unroll
        for (int kvb = 0; kvb < 2; ++kvb)
#pragma unroll
            for (int j = 0; j < 16; ++j) E[kvb][j] = __builtin_amdgcn_exp2f(E[kvb][j] - mx);
    }
    ATT_BAR();
    bool zE = false; int t = 0;
    while (t < NT - 1) {
    for (; t < NT - 1; ++t) {
        if (t + 2 < NT) ATT_DMA_K(t + 2);
        else if (has_next) ATT_DMA_KX(0, ngbase, ngko, nt0);
        ATT_DMA_V(t + 1);
        const ALAS unsigned char* vb = lds + (t & 1) * VBYTES + voff;
        ATT_QK(S, t + 1);
        ATT_SUMPACK();
#pragma unroll
        for (int i_ = 0; i_ < 8; ++i_) { __builtin_amdgcn_sched_group_barrier(0x008, 1, 0); __builtin_amdgcn_sched_group_barrier(0x002, 6, 0); }
        asm volatile("" : "+v"(pa[0][0]), "+v"(pa[0][1]), "+v"(pa[1][0]), "+v"(pa[1][1]), "+v"(lrun));
        ATT_VRD(0, vb);
        ATT_BIAS(S, t + 1);
        const float mx = rowmax(S[0], S[1]);
        float alpha = 1.f; const bool resc = __any(mx > 8.f);
        if (BR_B) zE = !resc && __all(mx < -136.f);
        if (resc) {
            const float dl = fmaxf(mx, 0.f); mref += dl; alpha = __builtin_amdgcn_exp2f(-dl); lrun *= alpha;
#pragma unroll
            for (int kvb = 0; kvb < 2; ++kvb)
#pragma unroll
                for (int j = 0; j < 16; ++j) S[kvb][j] -= dl;
#pragma unroll
            for (int j = 0; j < 16; ++j) cinit[j] = -mref;
        }
        ATT_PV(vb);
#pragma unroll
        for (int kvb = 0; kvb < 2; ++kvb)
#pragma unroll
            for (int j = 0; j < 16; ++j) E[kvb][j] = __builtin_amdgcn_exp2f(S[kvb][j]);
#pragma unroll
        for (int i_ = 0; i_ < NDB * 4; ++i_) { __builtin_amdgcn_sched_group_barrier(0x008, 1, 1); __builtin_amdgcn_sched_group_barrier(0x402, 32 / (NDB * 4), 1); }
        asm volatile("" : "+v"(E[0]), "+v"(E[1]));
        if (resc) {
#pragma unroll
            for (int i = 0; i < NDB; ++i) o[i] = o[i] * alpha;
        }
        asm volatile("s_waitcnt vmcnt(0)" ::: "memory"); ATT_BAR();
        if (BR_B && zE) { ++t; break; }
    }
    if (BR_B) {
        for (; t < NT - 1 && zE; ++t) {
            if (t + 2 < NT) ATT_DMA_K(t + 2);
            else if (has_next) ATT_DMA_KX(0, ngbase, ngko, nt0);
            ATT_DMA_V(t + 1);
            ATT_QK(S, t + 1);
            asm volatile("s_nop 11" : "+v"(S[0]), "+v"(S[1]));
            const float mxraw = rowmax(S[0], S[1]);
            const float dqt_ = dq + (float)(64 * (((t + 1) + t0) & (NT - 1)));
            const float dmin = fmaxf(fmaxf(dqt_ - 4.f, -(dqt_ + 63.f)), 0.f);
            if (!__all(mxraw - slope2 * dmin < -136.f)) {
                ATT_BIAS(S, t + 1);
                const float mx = rowmax(S[0], S[1]);
                const bool resc = __any(mx > 8.f);
                if (resc) {
                    const float dl = fmaxf(mx, 0.f); mref += dl; const float alpha = __builtin_amdgcn_exp2f(-dl); lrun *= alpha;
#pragma unroll
                    for (int kvb = 0; kvb < 2; ++kvb)
#pragma unroll
                        for (int j = 0; j < 16; ++j) S[kvb][j] -= dl;
#pragma unroll
                    for (int j = 0; j < 16; ++j) cinit[j] = -mref;
#pragma unroll
                    for (int i = 0; i < NDB; ++i) o[i] = o[i] * alpha;
                }
                zE = !resc && __all(mx < -136.f);
                if (!zE) {
#pragma unroll
                    for (int kvb = 0; kvb < 2; ++kvb)
#pragma unroll
                        for (int j = 0; j < 16; ++j) E[kvb][j] = __builtin_amdgcn_exp2f(S[kvb][j]);
                }
            }
            asm volatile("s_waitcnt vmcnt(0)" ::: "memory"); ATT_BAR();
        }
    }
    }
    const bf16_t* grow = P + (seqrow0 + q0 + wq * 32 + r) * DIN + ocol + 8 * h;
    u32x4 gq[NDB][2];
    if (!BR_B || grp == 0) {
#pragma unroll
        for (int db = 0; db < NDB; ++db)
#pragma unroll
            for (int gp = 0; gp < 2; ++gp) gq[db][gp] = *(const u32x4*)(grow + 32 * db + 16 * gp);
    }
    if (has_next) {
        ATT_DMA_KX(1, ngbase, ngko, nt0); ATT_DMA_VX(0, ngbase, ngvo, nt0);
        const int nqcol = BR_B ? (C_QB + nhead * 128 + grp * 64) : (C_QA + nhead * 64);
        const bf16_t* qp = P + ((size_t)nb * SEQ + nq0 + wq * 32 + r) * DIN + nqcol + 8 * h;
#pragma unroll
        for (int d0 = 0; d0 < 4; ++d0) qf[d0] = *(const bf16x8*)(qp + 16 * d0);
    }
    {
        const ALAS unsigned char* vb = lds + ((NT - 1) & 1) * VBYTES + voff;
        if (!(BR_B && zE)) { ATT_SUMPACK(); ATT_VRD(0, vb); ATT_PV(vb); }
    }
    ATT_BAR();
#undef ATT_BAR
#undef ATT_QK
#undef ATT_BIAS
#undef ATT_SUMPACK
#undef ATT_VRD
#undef ATT_PV
#undef ATT_DMA_K
#undef ATT_DMA_V
#undef ATT_DMA_KX
#undef ATT_DMA_VX
    const float inv = __builtin_amdgcn_rcpf(swap_add(lrun));
    bf16_t* orow = OUTP + (seqrow0 + q0 + wq * 32 + r) * (size_t)opitch + (ocol - (BR_B ? C_GB : C_GA)) + ocol_base + 8 * h;
    if (!BR_B) {
#pragma unroll
        for (int db = 0; db < NDB; ++db)
#pragma unroll
            for (int gp = 0; gp < 2; ++gp) { const u32x4 G = gq[db][gp]; const int g0 = 2 * gp, g1 = 2 * gp + 1;
                const auto r1 = __builtin_amdgcn_permlane32_swap(G.x, G.z, false, false), r2 = __builtin_amdgcn_permlane32_swap(G.y, G.w, false, false);
                u32x2 a, b;
                a.x = cvtpk(o[db][4 * g0] * inv * bf_lo(r1[0]), o[db][4 * g0 + 1] * inv * bf_hi(r1[0])); a.y = cvtpk(o[db][4 * g0 + 2] * inv * bf_lo(r2[0]), o[db][4 * g0 + 3] * inv * bf_hi(r2[0]));
                b.x = cvtpk(o[db][4 * g1] * inv * bf_lo(r1[1]), o[db][4 * g1 + 1] * inv * bf_hi(r1[1])); b.y = cvtpk(o[db][4 * g1 + 2] * inv * bf_lo(r2[1]), o[db][4 * g1 + 3] * inv * bf_hi(r2[1]));
                const auto s1 = __builtin_amdgcn_permlane32_swap(a.x, b.x, false, false), s2 = __builtin_amdgcn_permlane32_swap(a.y, b.y, false, false);
                *(u32x4*)(orow + 32 * db + 16 * gp) = (u32x4){s1[0], s2[0], s1[1], s2[1]}; }
        __syncthreads();
    } else {
        ALAS float* ex = (ALAS float*)(lds + 2 * BUF) + wq * 4096 + lane;
        if (grp == 1) {
#pragma unroll
            for (int db = 0; db < NDB; ++db)
#pragma unroll
                for (int j = 0; j < 16; ++j) ex[(db * 16 + j) * 64] = o[db][j] * inv;
        }
        __syncthreads();
        if (grp == 0) {
            float ss = 0.f;
#pragma unroll
            for (int db = 0; db < NDB; ++db)
#pragma unroll
                for (int j = 0; j < 16; ++j) { const float v = o[db][j] * inv - lam * ex[(db * 16 + j) * 64]; o[db][j] = v; ss += v * v; }
            ss = swap_add(ss);
            const float rs = __builtin_amdgcn_rsqf(ss * (1.f / 128.f) + EPS) * (1.f - LAM_INIT);
#pragma unroll
            for (int db = 0; db < NDB; ++db)
#pragma unroll
                for (int gp = 0; gp < 2; ++gp) { const u32x4 G = gq[db][gp]; const int g0 = 2 * gp, g1 = 2 * gp + 1;
                    const f32x4 sg0 = *(const f32x4*)(subg + 32 * db + 8 * g0 + 4 * h), sg1 = *(const f32x4*)(subg + 32 * db + 8 * g1 + 4 * h);
                    const auto r1 = __builtin_amdgcn_permlane32_swap(G.x, G.z, false, false), r2 = __builtin_amdgcn_permlane32_swap(G.y, G.w, false, false);
                    u32x2 a, b;
                    a.x = cvtpk(o[db][4 * g0] * rs * sg0[0] * bf_lo(r1[0]), o[db][4 * g0 + 1] * rs * sg0[1] * bf_hi(r1[0])); a.y = cvtpk(o[db][4 * g0 + 2] * rs * sg0[2] * bf_lo(r2[0]), o[db][4 * g0 + 3] * rs * sg0[3] * bf_hi(r2[0]));
                    b.x = cvtpk(o[db][4 * g1] * rs * sg1[0] * bf_lo(r1[1]), o[db][4 * g1 + 1] * rs * sg1[1] * bf_hi(r1[1])); b.y = cvtpk(o[db][4 * g1 + 2] * rs * sg1[2] * bf_lo(r2[1]), o[db][4 * g1 + 3] * rs * sg1[3] * bf_hi(r2[1]));
                    const auto s1 = __builtin_amdgcn_permlane32_swap(a.x, b.x, false, false), s2 = __builtin_amdgcn_permlane32_swap(a.y, b.y, false, false);
                    *(u32x4*)(orow + 32 * db + 16 * gp) = (u32x4){s1[0], s2[0], s1[1], s2[1]}; }
        }
        __syncthreads();
    }
}
}

#define LAS __attribute__((address_space(3)))

#define XB_TMO      128
#define XB_XCNT(j)  (256  + 64 * (j))
#define XB_XSUB(j)  (1280 + 64 * (j))
#define XB_XGEN(j)  (2304 + 64 * (j))
#define XB_TOP      3328
#define XB_TOPGEN   3392
#define XCD_BAR_WORDS 3456
#define XB_SPIN_CAP (1u << 18)

__device__ __forceinline__ unsigned xb_ld(unsigned* p)              { return __hip_atomic_load(p, __ATOMIC_RELAXED, __HIP_MEMORY_SCOPE_AGENT); }
__device__ __forceinline__ unsigned xb_add(unsigned* p, unsigned v) { return __hip_atomic_fetch_add(p, v, __ATOMIC_RELAXED, __HIP_MEMORY_SCOPE_AGENT); }
__device__ __forceinline__ unsigned xb_xcc_id() { return (unsigned)__builtin_amdgcn_s_getreg((3 << 11) | 20) & 0xFu; }
#define XB_SPIN(cond, bar) do { unsigned _sp = 0; while (cond) { __builtin_amdgcn_s_sleep(1); \
    if ((++_sp & 255u) == 0u) { if (xb_ld(&(bar)[XB_TMO])) break; if (_sp > XB_SPIN_CAP) { atomicAdd(&(bar)[XB_TMO], 1u); break; } } } } while (0)

struct XcdBarrier {
    unsigned* bar; unsigned x;
    volatile LAS unsigned* st;
};

__device__ __forceinline__ XcdBarrier xcd_barrier_post(unsigned* bar, volatile LAS unsigned* st) {
    XcdBarrier b; b.bar = bar; b.x = xb_xcc_id(); b.st = st;
    if (threadIdx.x == 0) (void)xb_add(&bar[XB_XCNT(b.x)], 1u);
    return b;
}
__device__ __forceinline__ void xcd_barrier_complete(unsigned* bar, unsigned x, unsigned& nloc, unsigned& nx) {
    const unsigned G = gridDim.x * gridDim.y * gridDim.z;
    unsigned sum, cnt, mine, sp = 0u;
    for (;;) {
        sum = 0u; cnt = 0u; mine = 0u;
#pragma unroll
        for (unsigned j = 0; j < 16; ++j) { const unsigned c = xb_ld(&bar[XB_XCNT(j)]); sum += c; cnt += (c > 0u) ? 1u : 0u; mine = (j == x) ? c : mine; }
        if (sum == G) break;
        __builtin_amdgcn_s_sleep(1);
        if ((++sp & 255u) == 0u) { if (xb_ld(&bar[XB_TMO])) break; if (sp > XB_SPIN_CAP) { atomicAdd(&bar[XB_TMO], 1u); break; } }
    }
    nloc = mine > 0u ? mine : 1u; nx = cnt > 0u ? cnt : 1u;
}

__device__ __forceinline__ void xcd_barrier(const XcdBarrier& b) {
    asm volatile("s_waitcnt vmcnt(0)" ::: "memory");
    __syncthreads();
    if (threadIdx.x == 0) {
        unsigned* bar = b.bar;
        __builtin_amdgcn_s_waitcnt(0);
        unsigned nloc = b.st[0], nx = b.st[1];
        if (nloc == 0u) { xcd_barrier_complete(bar, b.x, nloc, nx); b.st[0] = nloc; b.st[1] = nx; }
        const unsigned old = xb_add(&bar[XB_XSUB(b.x)], 1u);
        const unsigned gen = old / nloc;
        if (old + 1u == (gen + 1u) * nloc) {
            __builtin_amdgcn_fence(__ATOMIC_RELEASE, "agent");
            asm volatile("s_waitcnt vmcnt(0)" ::: "memory");
            const unsigned og = xb_add(&bar[XB_TOP], 1u);
            const unsigned tg = og / nx;
            if (og + 1u == (tg + 1u) * nx) xb_add(&bar[XB_TOPGEN], 1u);
            else XB_SPIN(xb_ld(&bar[XB_TOPGEN]) == tg, bar);
            __builtin_amdgcn_fence(__ATOMIC_ACQUIRE, "agent");
            xb_add(&bar[XB_XGEN(b.x)], 1u);
            asm volatile("s_waitcnt vmcnt(0)" ::: "memory");
        } else {
            XB_SPIN(xb_ld(&bar[XB_XGEN(b.x)]) == gen, bar);
            __builtin_amdgcn_fence(__ATOMIC_ACQUIRE, "agent");
            asm volatile("s_waitcnt vmcnt(0)" ::: "memory");
        }
    }
    __syncthreads();
}

typedef unsigned short bf16;
typedef float f32x4 __attribute__((ext_vector_type(4)));
typedef unsigned v4u __attribute__((ext_vector_type(4)));
typedef unsigned u32x2_t __attribute__((ext_vector_type(2)));
__device__ __forceinline__ unsigned f2bf(float f) { unsigned u = __builtin_bit_cast(unsigned, f); return (u + 0x7fffu + ((u >> 16) & 1u)) >> 16; }
__device__ __forceinline__ unsigned pk2(float lo, float hi) { return f2bf(lo) | (f2bf(hi) << 16); }
__device__ __forceinline__ float wave_sum(float v) {
#pragma unroll
    for (int o = 1; o < 64; o <<= 1) v += __shfl_xor(v, o);
    return v;
}
struct Params {
    const float *x_p, *x_s, *c_p, *c_s, *w_ada, *b_ada, *norm_g, *w_in, *a_q_norm, *a_k_norm, *lq1, *lk1, *lq2, *lk2, *sub_norm, *p_a, *p_b, *w_out, *final_g;
    float* out; unsigned char* ws;
};

__device__ __forceinline__ void transpose_item(const float* W, int K, int N, bf16* WT, int k0, int src_col0, int dst_row0, bool perm, LAS float* scr, int lane) {
#pragma unroll 8
    for (int i = 0; i < 32; ++i) { const int kk = 2 * i + (lane >> 5); scr[kk * 33 + (lane & 31)] = W[(size_t)(k0 + kk) * N + src_col0 + (lane & 31)]; }
    asm volatile("s_waitcnt lgkmcnt(0)" ::: "memory");
    const int c = lane & 7;
#pragma unroll
    for (int j = 0; j < 4; ++j) { const int n = (lane >> 3) + 8 * j; const int sn = perm ? (16 * ((n >> 2) & 1) + 4 * (n >> 3) + (n & 3)) : n; const LAS float* s = scr + (8 * c) * 33 + sn;
        v4u o; o.x = pk2(s[0 * 33], s[1 * 33]); o.y = pk2(s[2 * 33], s[3 * 33]); o.z = pk2(s[4 * 33], s[5 * 33]); o.w = pk2(s[6 * 33], s[7 * 33]);
        *(v4u*)(WT + (size_t)(dst_row0 + n) * K + k0 + 8 * c) = o; }
    asm volatile("s_waitcnt lgkmcnt(0)" ::: "memory");
}

__global__ void __launch_bounds__(NTHREADS, 2) fwd_kernel(Params p) {
    extern __shared__ __attribute__((aligned(16))) unsigned char lds_raw[];
    LAS unsigned char* lds = (LAS unsigned char*)lds_raw;
    cg::grid_group grid = cg::this_grid();
    const int tid = threadIdx.x, lane = tid & 63; const int wave = __builtin_amdgcn_readfirstlane(tid >> 6);
    const int G = gridDim.x, bx = blockIdx.x; const int vcu = (G % 8 == 0) ? (bx % 8) * (G / 8) + bx / 8 : bx;
    bf16* PROJ = (bf16*)(p.ws + WS_PROJ); bf16* WOUT_T = (bf16*)(p.ws + WS_WOUT); float* ADA = (float*)(p.ws + WS_ADA); float* RSS = (float*)(p.ws + WS_RSS);
    unsigned char* ob = (unsigned char*)p.out;
    bf16* H = (bf16*)(ob + DO_H); bf16* WIN_T = (bf16*)(ob + DO_WIN); bf16* PA_T = (bf16*)(ob + DO_PA); bf16* PB_T = (bf16*)(ob + DO_PB);
    const int gw = vcu * NWAVES + wave, NGW = G * NWAVES;
    volatile LAS unsigned* MISC = (volatile LAS unsigned*)(lds + 139264);
    if (tid < 2) MISC[tid] = 0u;
    __syncthreads();
    XcdBarrier xbar; xbar.bar = (unsigned*)(p.ws + WS_BAR); xbar.x = xb_xcc_id(); xbar.st = MISC;
    if (bx == G - 1) {
        for (int i = tid; i < 4096; i += NTHREADS) __hip_atomic_store(&xbar.bar[i], 0u, __ATOMIC_RELAXED, __HIP_MEMORY_SCOPE_AGENT);
        asm volatile("s_waitcnt vmcnt(0)" ::: "memory");
    }

    {
        LAS float* cact = (LAS float*)lds;
        LAS float* red = (LAS float*)(lds + 32768);
        for (int task = bx; task < 6 * 24; task += G) {
            const int bg = task / 24, n0 = (task % 24) * 128;
#pragma unroll
            for (int i = 0; i < 16; ++i) { const int idx = tid + 512 * i, bb = bg * 8 + (idx >> 10), k = idx & 1023;
                const float c = bb < NB_P ? p.c_p[(size_t)bb * D + k] : p.c_s[(size_t)(bb - NB_P) * D + k]; cact[idx] = c * sigmoidf_(c); }
            __syncthreads();
            const int ch = wave & 1, kq = wave >> 1, n = n0 + 64 * ch + lane;
            float acc[8];
#pragma unroll
            for (int i = 0; i < 8; ++i) acc[i] = 0.f;
            for (int k = kq * 256; k < kq * 256 + 256; k += 4) {
                float wv[4];
#pragma unroll
                for (int j = 0; j < 4; ++j) wv[j] = p.w_ada[(size_t)(k + j) * (3 * D) + n];
#pragma unroll
                for (int i = 0; i < 8; ++i) { const f32x4 cv = *(const LAS f32x4*)(cact + i * 1024 + k); acc[i] += cv[0] * wv[0] + cv[1] * wv[1] + cv[2] * wv[2] + cv[3] * wv[3]; }
            }
#pragma unroll
            for (int i = 0; i < 8; ++i) red[(kq * 8 + i) * 128 + 64 * ch + lane] = acc[i];
            __syncthreads();
#pragma unroll
            for (int i = 0; i < 2; ++i) { const int idx = tid + 512 * i, bb = idx >> 7, nn = idx & 127;
                const float s = (red[(0 * 8 + bb) * 128 + nn] + red[(1 * 8 + bb) * 128 + nn]) + (red[(2 * 8 + bb) * 128 + nn] + red[(3 * 8 + bb) * 128 + nn]);
                ADA[(size_t)(bg * 8 + bb) * (3 * D) + n0 + nn] = s + p.b_ada[n0 + nn]; }
            __syncthreads();
        }
        LAS float* scr = (LAS float*)(lds + wave * 16384);
        constexpr int I_IN = (DIN / 32) * (D / 64), I_PA = (D / 32) * (512 / 64), I_WO = (D / 32) * (D / 64), NITEMS = I_IN + 2 * I_PA + I_WO;
        for (int it = gw; it < NITEMS; it += NGW) {
            int rr = it;
            if (rr < I_IN) { const int g = rr / (D / 64), kb = rr % (D / 64); const int tile = g >> 3, bj = (g & 7) >> 2, wc = g & 3;
                int src; bool perm = false;
                if (tile < 2 || (tile == 2 && wc < 2)) { src = tile * 256 + 64 * wc + 32 * bj; perm = true; }
                else if (tile == 2) src = C_VA + (wc - 2) * 64 + 32 * bj;
                else src = 32 * g;
                transpose_item(p.w_in, D, DIN, WIN_T, 64 * kb, src, 32 * g, perm, scr, lane); continue; }
            rr -= I_IN;
            if (rr < I_PA) { const int g = rr / 8, kb = rr % 8; transpose_item(p.p_a, 512, D, PA_T, 64 * kb, 32 * g, 32 * g, false, scr, lane); continue; }
            rr -= I_PA;
            if (rr < I_PA) { const int g = rr / 8, kb = rr % 8; transpose_item(p.p_b, 512, D, PB_T, 64 * kb, 32 * g, 32 * g, false, scr, lane); continue; }
            rr -= I_PA;
            { const int g = rr / 16, kb = rr % 16; transpose_item(p.w_out, D, D, WOUT_T, 64 * kb, 32 * g, 32 * g, false, scr, lane); }
        }
    }
    grid.sync();
    if (tid == 0) (void)xb_add(&xbar.bar[XB_XCNT(xbar.x)], 1u);

    for (int m0 = gw; m0 < M; m0 += 2 * NGW) {
        const int m1 = (m0 + NGW < M) ? m0 + NGW : m0;
        const float* xr0 = (m0 < MP ? p.x_p + (size_t)m0 * D : p.x_s + (size_t)(m0 - MP) * D) + 4 * lane;
        const float* xr1 = (m1 < MP ? p.x_p + (size_t)m1 * D : p.x_s + (size_t)(m1 - MP) * D) + 4 * lane;
        f32x4 v0[4], v1[4]; float s0 = 0.f, s1 = 0.f;
#pragma unroll
        for (int j = 0; j < 4; ++j) { v0[j] = __builtin_nontemporal_load((const f32x4*)(xr0 + 256 * j)); v1[j] = __builtin_nontemporal_load((const f32x4*)(xr1 + 256 * j)); }
#pragma unroll
        for (int j = 0; j < 4; ++j) { s0 += (v0[j][0] * v0[j][0] + v0[j][1] * v0[j][1]) + (v0[j][2] * v0[j][2] + v0[j][3] * v0[j][3]); s1 += (v1[j][0] * v1[j][0] + v1[j][1] * v1[j][1]) + (v1[j][2] * v1[j][2] + v1[j][3] * v1[j][3]); }
        const float rs0 = __builtin_amdgcn_rsqf(wave_sum(s0) * (1.f / D) + EPS), rs1 = __builtin_amdgcn_rsqf(wave_sum(s1) * (1.f / D) + EPS);
        const float* ad0 = ADA + (size_t)(m0 / SEQ) * (3 * D) + 4 * lane; const float* ad1 = ADA + (size_t)(m1 / SEQ) * (3 * D) + 4 * lane;
        unsigned long long* o0 = (unsigned long long*)(H + (size_t)m0 * D) + lane; unsigned long long* o1 = (unsigned long long*)(H + (size_t)m1 * D) + lane;
#pragma unroll
        for (int j = 0; j < 4; ++j) { const f32x4 g = *(const f32x4*)(p.norm_g + 4 * lane + 256 * j);
            const f32x4 h0 = v0[j] * rs0 * g * (*(const f32x4*)(ad0 + D + 256 * j) + 1.f) + *(const f32x4*)(ad0 + 256 * j);
            const f32x4 h1 = v1[j] * rs1 * g * (*(const f32x4*)(ad1 + D + 256 * j) + 1.f) + *(const f32x4*)(ad1 + 256 * j);
            o0[64 * j] = (unsigned long long)pk2(h0[0], h0[1]) | ((unsigned long long)pk2(h0[2], h0[3]) << 32);
            if (m1 != m0) o1[64 * j] = (unsigned long long)pk2(h1[0], h1[1]) | ((unsigned long long)pk2(h1[2], h1[3]) << 32); }
    }
    xcd_barrier(xbar);

    {
        pg8::Gemm g{H, WIN_T, M, DIN, D, D}; pg8::StaticOrder S; S.init(M, DIN, G, bx);
        pg8::EpiInProj E{PROJ, p.a_q_norm, p.a_k_norm};
        for (int rep = 0; rep < P2_REPS; ++rep) pg8::gemm_phase<pg8::EpiInProj, pg8::StaticOrder, true, true>(lds, g, S, E);
    }
    xcd_barrier(xbar);

    {
        float lam;
        { const float a = wave_sum(p.lq1[lane] * p.lk1[lane]), b2 = wave_sum(p.lq2[lane] * p.lk2[lane]); lam = __builtin_amdgcn_exp2f(a * LOG2E) - __builtin_amdgcn_exp2f(b2 * LOG2E) + LAM_INIT; }
        for (int rep = 0; rep < ATT_REPS; ++rep) {
        const bool real = (rep == ATT_REPS - 1);
        bf16* OUTP_ = real ? PROJ : H; const int OPITCH_ = real ? DIN : D; const int OCA_ = real ? C_GA : 0; const int OCB_ = real ? C_GB : 512;
        if (G == 256) {
            const int xcd = bx & 7, j = bx >> 3;
            att::bf16x8 qfc[4];
            for (int i = 0; i < 12; ++i) { const int pair = 12 * xcd + i, np = pair + 1; att::attn_unit<false>(lds, PROJ, pair >> 1, (pair & 1) * 4 + (j >> 3), j & 7, 0.f, nullptr, OUTP_, OPITCH_, OCA_,
                qfc, i == 0, i + 1 < 12, np >> 1, (np & 1) * 4 + (j >> 3), j & 7); }
            for (int i = 0; i < 12; ++i) {
                const int pp = 2 * i + (j >> 4), bl = pp >> 2, hd = ((pp & 3) + bl) & 3, pn = pp + 2, bln = pn >> 2, hdn = ((pn & 3) + bln) & 3;
                const int qbi = ((j & 15) + 5 * i) & 15, qbn = ((j & 15) + 5 * (i + 1)) & 15;
                att::attn_unit<true>(lds, PROJ, 6 * xcd + bl, hd, qbi, lam, p.sub_norm, OUTP_, OPITCH_, OCB_, qfc, i == 0, i + 1 < 12, 6 * xcd + bln, hdn, qbn); }
        } else {
            const int nA = NB * 8 * 8, nB = NB * 4 * 16;
            for (int u = bx; u < nA + nB; u += G) {
                att::bf16x8 qfg[4];
                if (u < nA) att::attn_unit<false>(lds, PROJ, u >> 6, (u >> 3) & 7, u & 7, 0.f, nullptr, OUTP_, OPITCH_, OCA_, qfg, true, false, 0, 0, 0);
                else { const int v = u - nA; att::attn_unit<true>(lds, PROJ, v >> 6, (v >> 4) & 3, v & 15, lam, p.sub_norm, OUTP_, OPITCH_, OCB_, qfg, true, false, 0, 0, 0); }
            }
        }
        }
    }
    xcd_barrier(xbar);

    {
        pg8::StaticOrder S; S.init(M, D, G, bx);
        { pg8::Gemm g{PROJ + C_GA, PA_T, M, D, 512, DIN}; pg8::EpiMerge<0> E{PROJ}; pg8::gemm_phase<pg8::EpiMerge<0>, pg8::StaticOrder, true, true>(lds, g, S, E); }
        { pg8::Gemm g{PROJ + C_GB, PB_T, M, D, 512, DIN}; pg8::EpiMerge<1> E{PROJ}; pg8::gemm_phase<pg8::EpiMerge<1>, pg8::StaticOrder, true, true>(lds, g, S, E); }
    }
    xcd_barrier(xbar);

    {
        pg8::Gemm g{PROJ + C_MERGED, WOUT_T, M, D, D, DIN}; pg8::StaticOrder S; S.init(M, D, G, bx);
        pg8::EpiOut E{p.x_p, p.x_s, ADA, PROJ, RSS};
        pg8::gemm_phase<pg8::EpiOut, pg8::StaticOrder, true, true>(lds, g, S, E);
    }
    xcd_barrier(xbar);

    for (int m0 = gw; m0 < M; m0 += 2 * NGW) {
        const int m1 = (m0 + NGW < M) ? m0 + NGW : m0;
        float s0 = RSS[(size_t)m0 * 16 + (lane & 15)], s1 = RSS[(size_t)m1 * 16 + (lane & 15)];
        const bf16* yr0 = PROJ + (size_t)m0 * DIN + 4 * lane; const bf16* yr1 = PROJ + (size_t)m1 * DIN + 4 * lane;
        u32x2_t y0[4], y1[4];
#pragma unroll
        for (int j = 0; j < 4; ++j) { y0[j] = __builtin_nontemporal_load((const u32x2_t*)(yr0 + 256 * j)); y1[j] = __builtin_nontemporal_load((const u32x2_t*)(yr1 + 256 * j)); }
        s0 += __shfl_xor(s0, 1); s0 += __shfl_xor(s0, 2); s0 += __shfl_xor(s0, 4); s0 += __shfl_xor(s0, 8);
        s1 += __shfl_xor(s1, 1); s1 += __shfl_xor(s1, 2); s1 += __shfl_xor(s1, 4); s1 += __shfl_xor(s1, 8);
        const float rs0 = __builtin_amdgcn_rsqf(s0 * (1.f / D) + EPS), rs1 = __builtin_amdgcn_rsqf(s1 * (1.f / D) + EPS);
        float* o0 = p.out + (size_t)m0 * D + 4 * lane; float* o1 = p.out + (size_t)m1 * D + 4 * lane;
#pragma unroll
        for (int j = 0; j < 4; ++j) { const f32x4 g = *(const f32x4*)(p.final_g + 4 * lane + 256 * j);
            const f32x4 a0 = {bf_lo(y0[j].x), bf_hi(y0[j].x), bf_lo(y0[j].y), bf_hi(y0[j].y)}, a1 = {bf_lo(y1[j].x), bf_hi(y1[j].x), bf_lo(y1[j].y), bf_hi(y1[j].y)};
            __builtin_nontemporal_store(a0 * rs0 * g, (f32x4*)(o0 + 256 * j));
            if (m1 != m0) __builtin_nontemporal_store(a1 * rs1 * g, (f32x4*)(o1 + 256 * j)); }
    }
}

extern "C" void kernel_launch(void* const* d_in, const int* in_sizes, int n_in, void* d_out, int out_size, void* d_ws, size_t ws_size, hipStream_t stream) {
    static int grid = 0;
    if (grid == 0) {
        if (n_in != 19 || out_size != M * D || ws_size < WS_END) { fprintf(stderr, "kernel_launch: unexpected sizes n_in %d out %d ws %zu\n", n_in, out_size, ws_size); grid = -1; return; }
        int dev = 0, cus = 0, per_cu = 0;
        hipGetDevice(&dev); hipDeviceGetAttribute(&cus, hipDeviceAttributeMultiprocessorCount, dev);
        hipFuncSetAttribute((const void*)fwd_kernel, hipFuncAttributeMaxDynamicSharedMemorySize, LDS_BYTES);
        hipOccupancyMaxActiveBlocksPerMultiprocessor(&per_cu, (const void*)fwd_kernel, NTHREADS, LDS_BYTES);
        if (per_cu < 1) { fprintf(stderr, "kernel_launch: occupancy query says %d blocks per CU\n", per_cu); per_cu = 1; }
        (void)hipGetLastError();
        grid = cus;
    }
    if (grid < 0) return;
    Params p{};
    p.x_p = (const float*)d_in[0]; p.x_s = (const float*)d_in[1]; p.c_p = (const float*)d_in[2]; p.c_s = (const float*)d_in[3]; p.w_ada = (const float*)d_in[4]; p.b_ada = (const float*)d_in[5];
    p.norm_g = (const float*)d_in[6]; p.w_in = (const float*)d_in[7]; p.a_q_norm = (const float*)d_in[8]; p.a_k_norm = (const float*)d_in[9]; p.lq1 = (const float*)d_in[10]; p.lk1 = (const float*)d_in[11];
    p.lq2 = (const float*)d_in[12]; p.lk2 = (const float*)d_in[13]; p.sub_norm = (const float*)d_in[14]; p.p_a = (const float*)d_in[15]; p.p_b = (const float*)d_in[16]; p.w_out = (const float*)d_in[17]; p.final_g = (const float*)d_in[18];
    p.out = (float*)d_out; p.ws = (unsigned char*)d_ws;
    void* args[] = {&p};
    hipError_t e = hipLaunchCooperativeKernel((const void*)fwd_kernel, dim3(grid), dim3(NTHREADS), args, LDS_BYTES, stream);
    if (e != hipSuccess) fprintf(stderr, "cooperative launch failed: %s (grid %d)\n", hipGetErrorString(e), grid);
}
```
